# Optimizing an MI355X kernel written in HIP

```python
import math
import jax, jax.numpy as jnp
from jax import lax
import numpy as np

D_MODEL = 1024
BATCH = 4
SEQ = 4096
DEPTH = 2

N_MEM = 256
NORM_EPS = 1e-6
ROPE_THETA = 500000.0
HEAD_DIM = 64
ROT_DIM = HEAD_DIM // 4
BLOCK = 128
LRU_WIDTH = D_MODEL
LRU_HEADS = 4
LRU_HEAD_DIM = LRU_WIDTH // LRU_HEADS
CONV_WIDTH = 4
LRU_C = 8.0
B_HEADS = 8
B_WIDTH = B_HEADS * HEAD_DIM
DILATED_PATTERN = ((128, 1), (512, 4), (2048, 16))
C_HEADS = 16
C_KV_HEADS = 2
C_WINDOW = 128
C_Q_WIDTH = C_HEADS * HEAD_DIM
C_KV_WIDTH = C_KV_HEADS * HEAD_DIM
C_QKV = C_Q_WIDTH + 2 * C_KV_WIDTH
XA_HEADS = 4
XA_HEAD_DIM = 128
XA_WIDTH = XA_HEADS * XA_HEAD_DIM
D_FF = -(-8 * D_MODEL // (3 * 256)) * 256
AB_IN = 2 * LRU_WIDTH + 3 * B_WIDTH
AB_SPLITS = (LRU_WIDTH, 2 * LRU_WIDTH, 2 * LRU_WIDTH + B_WIDTH, 2 * LRU_WIDTH + 2 * B_WIDTH)
AB_OUT = LRU_WIDTH + B_WIDTH
N_EVEN = (DEPTH + 1) // 2
N_ODD = DEPTH // 2
NEG = -1e30

kernel_name = "hybrid_rglru_dilated_swa_sink_block"


def rms_norm(x, g):
    xf = x.astype(jnp.float32)
    xf = xf * lax.rsqrt(jnp.mean(xf * xf, axis=-1, keepdims=True) + NORM_EPS)
    return (xf * g.astype(jnp.float32)).astype(x.dtype)


def rope_tables(L):
    inv = ROPE_THETA ** (-jnp.arange(0, ROT_DIM, 2, dtype=jnp.float32) / ROT_DIM)
    ang = jnp.arange(L, dtype=jnp.float32)[:, None] * inv[None, :]
    return jnp.cos(ang), jnp.sin(ang)


def partial_rope(x, cos, sin):
    half = ROT_DIM // 2
    cos = cos.astype(x.dtype)
    sin = sin.astype(x.dtype)
    x1 = x[..., :half]
    x2 = x[..., half:ROT_DIM]
    return jnp.concatenate([x1 * cos - x2 * sin, x2 * cos + x1 * sin, x[..., ROT_DIM:]], axis=-1)


def banded_attention(q, k, v, max_dist, sinks=None):
    Bsz, Hq, L, hd = q.shape
    Hkv = k.shape[1]
    G = Hq // Hkv
    nb = -(-L // BLOCK)
    Lp = nb * BLOCK
    pad = ((0, 0), (0, 0), (0, Lp - L), (0, 0))
    qb = jnp.pad(q, pad).reshape(Bsz, Hkv, G, nb, BLOCK, hd)
    kb = jnp.pad(k, pad).reshape(Bsz, Hkv, nb, BLOCK, hd)
    vb = jnp.pad(v, pad).reshape(Bsz, Hkv, nb, BLOCK, hd)

    def band(t):
        prev = jnp.pad(t, ((0, 0), (0, 0), (1, 0), (0, 0), (0, 0)))[:, :, :nb]
        return jnp.concatenate([prev, t], axis=3)

    kband, vband = band(kb), band(vb)
    s = jnp.einsum('bhgnqd,bhnkd->bhgnqk', qb, kband).astype(jnp.float32) * (hd ** -0.5)
    blk = jnp.arange(nb)[:, None, None]
    qpos = blk * BLOCK + jnp.arange(BLOCK)[None, :, None]
    kpos = (blk - 1) * BLOCK + jnp.arange(2 * BLOCK)[None, None, :]
    dist = qpos - kpos
    mask = (dist >= 0) & (dist <= max_dist) & (kpos >= 0)
    s = jnp.where(mask, s, NEG)
    m = jnp.max(s, axis=-1, keepdims=True)
    if sinks is not None:
        sk = sinks.astype(jnp.float32).reshape(1, Hkv, G, 1, 1, 1)
        m = jnp.maximum(m, sk)
        e = jnp.exp(s - m)
        den = jnp.sum(e, axis=-1, keepdims=True) + jnp.exp(sk - m)
    else:
        e = jnp.exp(s - m)
        den = jnp.sum(e, axis=-1, keepdims=True)
    p = e / den
    lse = (m + jnp.log(den))[..., 0]
    o = jnp.einsum('bhgnqk,bhnkd->bhgnqd', p.astype(v.dtype), vband)
    o = o.reshape(Bsz, Hq, Lp, hd)[:, :, :L]
    lse = lse.reshape(Bsz, Hq, Lp)[:, :, :L]
    return o, lse


def dilated_attention(q, k, v):
    Bsz, H, L, hd = q.shape
    outs, lses = [], []
    for window, d in DILATED_PATTERN:
        Ld = L // d

        def to_strided(t):
            return t.reshape(Bsz, H, Ld, d, hd).transpose(0, 1, 3, 2, 4).reshape(Bsz, H * d, Ld, hd)

        o, lse = banded_attention(to_strided(q), to_strided(k), to_strided(v), window // d)
        outs.append(o.reshape(Bsz, H, d, Ld, hd).transpose(0, 1, 3, 2, 4).reshape(Bsz, H, L, hd))
        lses.append(lse.reshape(Bsz, H, d, Ld).transpose(0, 1, 3, 2).reshape(Bsz, H, L))
    w = jax.nn.softmax(jnp.stack(lses, axis=0), axis=0)
    o = jnp.sum(w[..., None] * jnp.stack(outs, axis=0).astype(jnp.float32), axis=0)
    return o.astype(q.dtype)


def causal_depthwise_conv(x, w, b):
    L = x.shape[1]
    xp = jnp.pad(x, ((0, 0), (CONV_WIDTH - 1, 0), (0, 0)))
    y = b + xp[:, 0:L] * w[0]
    for tap in range(1, CONV_WIDTH):
        y = y + xp[:, tap:tap + L] * w[tap]
    return y


def block_diag_linear(x, w, b):
    Bsz, L, _ = x.shape
    xh = x.reshape(Bsz, L, LRU_HEADS, LRU_HEAD_DIM)
    y = jnp.einsum('blhi,hij->blhj', xh, w) + b
    return y.reshape(Bsz, L, LRU_WIDTH)


def rg_lru(x, wa, ba, wx, bx, lam):
    r = jax.nn.sigmoid(block_diag_linear(x, wa, ba).astype(jnp.float32))
    i = jax.nn.sigmoid(block_diag_linear(x, wx, bx).astype(jnp.float32))
    log_a = -LRU_C * r * jax.nn.softplus(-lam.astype(jnp.float32))
    a = jnp.exp(log_a)
    u = jnp.sqrt(-jnp.expm1(2.0 * log_a)) * (i * x.astype(jnp.float32))

    def combine(left, right):
        a1, b1 = left
        a2, b2 = right
        return a1 * a2, a2 * b1 + b2

    _, h = lax.associative_scan(combine, (a, u), axis=1)
    return h.astype(x.dtype)


def lru_dilated_mixer(h, cos, sin, w_in, conv_w, conv_b, wa, ba, wx, bx, lam, w_out):
    Bsz, L, _ = h.shape
    proj = h @ w_in
    x_br, y_br, q, k, v = jnp.split(proj, list(AB_SPLITS), axis=-1)
    rec = rg_lru(causal_depthwise_conv(x_br, conv_w, conv_b), wa, ba, wx, bx, lam) * jax.nn.gelu(y_br)

    def heads(t):
        return t.reshape(Bsz, L, B_HEADS, HEAD_DIM).transpose(0, 2, 1, 3)

    q = partial_rope(heads(q), cos, sin)
    k = partial_rope(heads(k), cos, sin)
    att = dilated_attention(q, k, heads(v)).transpose(0, 2, 1, 3).reshape(Bsz, L, B_WIDTH)
    return jnp.concatenate([rec, att], axis=-1) @ w_out


def swa_sink_mixer(h, cos, sin, w_qkv, b_qkv, sinks, w_out, b_out):
    Bsz, L, _ = h.shape
    proj = h @ w_qkv + b_qkv
    q, k, v = jnp.split(proj, [C_Q_WIDTH, C_Q_WIDTH + C_KV_WIDTH], axis=-1)
    q = partial_rope(q.reshape(Bsz, L, C_HEADS, HEAD_DIM).transpose(0, 2, 1, 3), cos, sin)
    k = partial_rope(k.reshape(Bsz, L, C_KV_HEADS, HEAD_DIM).transpose(0, 2, 1, 3), cos, sin)
    v = v.reshape(Bsz, L, C_KV_HEADS, HEAD_DIM).transpose(0, 2, 1, 3)
    o, _ = banded_attention(q, k, v, C_WINDOW - 1, sinks)
    return o.transpose(0, 2, 1, 3).reshape(Bsz, L, C_Q_WIDTH) @ w_out + b_out


def memory_cross_attention(h, mem_n, wq, wkv, wo):
    Bsz, L, _ = h.shape
    M = mem_n.shape[1]
    q = (h @ wq).reshape(Bsz, L, XA_HEADS, XA_HEAD_DIM)
    k, v = jnp.split(mem_n @ wkv, 2, axis=-1)
    k = k.reshape(Bsz, M, XA_HEADS, XA_HEAD_DIM)
    v = v.reshape(Bsz, M, XA_HEADS, XA_HEAD_DIM)
    s = jnp.einsum('blhd,bmhd->bhlm', q, k).astype(jnp.float32) * (XA_HEAD_DIM ** -0.5)
    p = jax.nn.softmax(s, axis=-1)
    o = jnp.einsum('bhlm,bmhd->blhd', p.astype(v.dtype), v).reshape(Bsz, L, XA_WIDTH)
    return o @ wo


def swiglu(h, w_gate_up, w_down):
    gate, up = jnp.split(h @ w_gate_up, 2, axis=-1)
    return (jax.nn.silu(gate) * up) @ w_down


def setup_inputs(seed: int = 0) -> dict:
    key = jax.random.key(seed)
    ks = jax.random.split(key, 32)
    f32 = jnp.float32

    def nrm(k, shape, fan_in):
        return jax.random.normal(k, shape, f32) * (fan_in ** -0.5)

    def gain(k, shape):
        return 1.0 + 0.02 * jax.random.normal(k, shape, f32)

    def small(k, shape):
        return 0.01 * jax.random.normal(k, shape, f32)

    a_c = jax.random.uniform(ks[8], (N_EVEN, LRU_WIDTH), f32, 0.9, 0.999)
    a0 = a_c ** (1.0 / LRU_C)
    lru_lambda = jnp.log(a0) - jnp.log1p(-a0)

    return {
        "x": jax.random.normal(ks[0], (BATCH, SEQ, D_MODEL), f32),
        "mem": jax.random.normal(ks[1], (BATCH, N_MEM, D_MODEL), f32),
        "mix_norm": gain(ks[2], (DEPTH, D_MODEL)),
        "ab_w_in": nrm(ks[3], (N_EVEN, D_MODEL, AB_IN), D_MODEL),
        "lru_conv_w": nrm(ks[4], (N_EVEN, CONV_WIDTH, LRU_WIDTH), CONV_WIDTH),
        "lru_conv_b": small(ks[5], (N_EVEN, LRU_WIDTH)),
        "lru_wa": nrm(ks[6], (N_EVEN, LRU_HEADS, LRU_HEAD_DIM, LRU_HEAD_DIM), LRU_HEAD_DIM),
        "lru_ba": small(ks[7], (N_EVEN, LRU_HEADS, LRU_HEAD_DIM)),
        "lru_wx": nrm(ks[9], (N_EVEN, LRU_HEADS, LRU_HEAD_DIM, LRU_HEAD_DIM), LRU_HEAD_DIM),
        "lru_bx": small(ks[10], (N_EVEN, LRU_HEADS, LRU_HEAD_DIM)),
        "lru_lambda": lru_lambda,
        "ab_w_out": nrm(ks[11], (N_EVEN, AB_OUT, D_MODEL), AB_OUT),
        "c_w_qkv": nrm(ks[12], (N_ODD, D_MODEL, C_QKV), D_MODEL),
        "c_b_qkv": small(ks[13], (N_ODD, C_QKV)),
        "c_sinks": 0.5 * jax.random.normal(ks[14], (N_ODD, C_HEADS), f32),
        "c_w_out": nrm(ks[15], (N_ODD, C_Q_WIDTH, D_MODEL), C_Q_WIDTH),
        "c_b_out": small(ks[16], (N_ODD, D_MODEL)),
        "xa_norm": gain(ks[17], (DEPTH, D_MODEL)),
        "xa_mem_norm": gain(ks[18], (DEPTH, D_MODEL)),
        "xa_wq": nrm(ks[19], (DEPTH, D_MODEL, XA_WIDTH), D_MODEL),
        "xa_wkv": nrm(ks[20], (DEPTH, D_MODEL, 2 * XA_WIDTH), D_MODEL),
        "xa_wo": nrm(ks[21], (DEPTH, XA_WIDTH, D_MODEL), XA_WIDTH),
        "ffn_norm": gain(ks[22], (DEPTH, D_MODEL)),
        "ffn_w_gate_up": nrm(ks[23], (DEPTH, D_MODEL, 2 * D_FF), D_MODEL),
        "ffn_w_down": nrm(ks[24], (DEPTH, D_FF, D_MODEL), D_FF),
        "final_norm": gain(ks[25], (D_MODEL,)),
    }


def reference(x, mem, mix_norm, ab_w_in, lru_conv_w, lru_conv_b, lru_wa, lru_ba, lru_wx, lru_bx,
              lru_lambda, ab_w_out, c_w_qkv, c_b_qkv, c_sinks, c_w_out, c_b_out, xa_norm,
              xa_mem_norm, xa_wq, xa_wkv, xa_wo, ffn_norm, ffn_w_gate_up, ffn_w_down, final_norm):
    cos, sin = rope_tables(x.shape[1])
    h = x
    for layer in range(DEPTH):
        j = layer // 2
        hn = rms_norm(h, mix_norm[layer])
        if layer % 2 == 0:
            h = h + lru_dilated_mixer(hn, cos, sin, ab_w_in[j], lru_conv_w[j], lru_conv_b[j],
                                      lru_wa[j], lru_ba[j], lru_wx[j], lru_bx[j], lru_lambda[j],
                                      ab_w_out[j])
        else:
            h = h + swa_sink_mixer(hn, cos, sin, c_w_qkv[j], c_b_qkv[j], c_sinks[j],
                                   c_w_out[j], c_b_out[j])
        h = h + memory_cross_attention(rms_norm(h, xa_norm[layer]), rms_norm(mem, xa_mem_norm[layer]),
                                       xa_wq[layer], xa_wkv[layer], xa_wo[layer])
        h = h + swiglu(rms_norm(h, ffn_norm[layer]), ffn_w_gate_up[layer], ffn_w_down[layer])
    return rms_norm(h, final_norm)
```

```cpp
#include <hip/hip_runtime.h>
#include <hip/hip_cooperative_groups.h>
#include <cstdio>
#include <cstdint>
namespace cg = cooperative_groups;

#ifndef HOST_REP_MASK
#define HOST_REP_MASK 0
#endif
#ifndef MK_SPLIT
#define MK_SPLIT 0
#endif

#define LAS __attribute__((address_space(3)))
typedef unsigned short bf16_t;
typedef short bf16x8 __attribute__((ext_vector_type(8)));
typedef float f32x4 __attribute__((ext_vector_type(4)));
typedef float f32x2 __attribute__((ext_vector_type(2)));
typedef unsigned u32x4 __attribute__((ext_vector_type(4)));
typedef unsigned u32x2 __attribute__((ext_vector_type(2)));

constexpr int M = 16384, SEQ = 4096, NB = 4, DM = 1024, DFF = 2816, NMEM = 256;
constexpr float EPS = 1e-6f;
constexpr size_t MiB = 1u << 20;
constexpr size_t WS_PCNT = 16384;
constexpr size_t WS_SS = 1 * MiB;
constexpr size_t WS_ROPE = 2 * MiB;
constexpr size_t WS_CA = 3 * MiB, WS_CH = 4 * MiB;
constexpr size_t WS_MEM16 = 5 * MiB;
constexpr size_t WS_MEMKV = 7 * MiB;
constexpr size_t WS_WIN = 12 * MiB;
constexpr size_t WS_GT = 19 * MiB;
constexpr size_t WS_WOUT = 20 * MiB;
constexpr size_t WS_CQKV = 23 * MiB;
constexpr size_t WS_COUT = WS_CQKV + 2560 * 1024;
constexpr size_t WS_XAQ = WS_COUT + 2 * MiB;
constexpr size_t WS_XAKV = WS_XAQ + 2 * MiB;
constexpr size_t WS_XAO = WS_XAKV + 4 * MiB;
constexpr size_t WS_GU = WS_XAO + 2 * MiB;
constexpr size_t WS_DN = WS_GU + 22 * MiB;
constexpr size_t WS_H16 = 70 * MiB;
constexpr size_t WS_ACT = 104 * MiB;
static_assert(WS_DN + 11 * MiB <= WS_H16, "weights fit");
constexpr size_t A_XBR = WS_ACT, A_YG = WS_ACT + 32 * MiB, A_Q = WS_ACT + 64 * MiB, A_K = A_Q + 16 * MiB, A_V = A_K + 16 * MiB, A_CAT = A_Q, A_U = WS_ACT + 112 * MiB;
constexpr size_t A_XQ = WS_ACT, A_XO = WS_ACT + 16 * MiB, A_FF = WS_ACT, A_Q1 = WS_ACT, A_KV1 = WS_ACT + 32 * MiB, A_O1 = WS_ACT + 40 * MiB;
static_assert(A_U + 32 * MiB <= 256 * MiB, "ws fits");
static_assert(A_K - A_Q == 16 * MiB && A_V - A_K == 16 * MiB, "q|k|v spacing used by EpiProj0");
constexpr size_t OUT_LSE = 48 * MiB;

namespace pg8 {
constexpr int BM = 256, BK = 64, HALF = 128, HTB = HALF * BK * 2, STAGE_BYTES = 8 * HTB, NXCD = 8, WGM = 8;
__host__ __device__ __forceinline__ int lds_byte(int r, int c) { const int st = (r >> 4) * 2 + (c >> 5), rr = r & 15, cc = c & 31, ob = rr * 64 + cc * 2; return st * 1024 + (ob ^ (((ob >> 9) & 1) << 5)); }
__host__ __device__ __forceinline__ void stage_rc(int b, int& R, int& C) { const int st = b / 1024, sb = b % 1024, swz = sb ^ (((sb >> 9) & 1) << 5); R = (st >> 1) * 16 + swz / 64; C = (st & 1) * 32 + (swz % 64) / 2; }
__host__ __device__ __forceinline__ int perm32(int rho) { const int n = rho >> 4, i = rho & 15; return 8 * (i >> 2) + 4 * n + (i & 3); }

struct Unit { int pm, pn, nh, h0; };
struct Gemm { const bf16_t* A; const bf16_t* Bt; int M, N, K, lda, ldb, a_shift, a_goff; };

struct StaticOrder {
    int nM, nN, nwg, G, c, nfull, rem; bool th;
    __host__ __device__ __forceinline__ void init(int M_, int N_, int G_, int c_, bool halves = false) { nM = M_ / BM; nN = N_ / BM; nwg = nM * nN; G = G_; c = c_; rem = nwg % G; nfull = nwg - rem; th = halves && rem > 0 && 2 * rem <= G; }
    __host__ __device__ __forceinline__ bool next(int i, Unit& u) const {
        const long L = (long)i * G + c; int wgid; u.nh = 2; u.h0 = 0;
        if (th && L >= nfull) { const long e = L - nfull; if (e >= 2 * rem) return false; wgid = nfull + (int)(e >> 1); u.h0 = (int)(e & 1); u.nh = 1; }
        else { if (L >= nwg) return false; wgid = (int)L; }
        { const int q = nwg / NXCD, r = nwg % NXCD, xcd = wgid % NXCD, off = wgid / NXCD; wgid = (xcd < r ? xcd * (q + 1) : r * (q + 1) + (xcd - r) * q) + off; }
        const int nig = WGM * nN, gid = wgid / nig, fm = gid * WGM, gsz = (nM - fm) < WGM ? (nM - fm) : WGM;
        u.pm = fm + ((wgid % nig) % gsz); u.pn = (wgid % nig) / gsz; return true;
    }
};

template <bool HALVES = false, class Epi>
__device__ __forceinline__ void gemm_phase(LAS unsigned char* lds, const Gemm g, const StaticOrder& S, const Epi& E) {
    const int tid = threadIdx.x, wid = __builtin_amdgcn_readfirstlane(tid >> 6), lane = tid & 63, wr = wid >> 2, wc = wid & 3, fr = lane & 15, fq = lane >> 4;
    const int K = g.K, nt = K / BK;
    unsigned voffA[2], voffB[2];
#pragma unroll
    for (int i = 0; i < 2; ++i) { int R, C; stage_rc(tid * 16 + i * 8192, R, C); const int Rb = (R & ~31) + perm32(R & 31);
        voffA[i] = (unsigned)(R * g.lda + C) * 2u; voffB[i] = (unsigned)(Rb * g.ldb + C) * 2u; }
    constexpr unsigned kstep = BK * 2;
    const unsigned hstepA = (unsigned)HALF * g.lda * 2u, hstepB = (unsigned)HALF * g.ldb * 2u;
    const unsigned tstepA = 2 * hstepA, tstepB = 2 * hstepB;
    const unsigned ldsw = (unsigned)wid * 1024u;
    const int aoff = lds_byte(wr * 64 + fr, fq * 8), boff = lds_byte(wc * 32 + fr, fq * 8);
#define PG8_SA(b, h) (((b) * 2 + (h)) * HTB)
#define PG8_SB(b, h) ((4 + (b) * 2 + (h)) * HTB)
#define PG8_STAGE(bufoff, gbase, voff) do { _Pragma("unroll") for (int _i = 0; _i < 2; ++_i) \
        __builtin_amdgcn_global_load_lds((const unsigned*)((const char*)(gbase) + (voff)[_i]), (LAS unsigned*)(lds + (bufoff) + ldsw + _i * 8192), 16, 0, 0); } while (0)
#define PG8_LDA(dst, b, h) do { _Pragma("unroll") for (int m = 0; m < 4; ++m) _Pragma("unroll") for (int k = 0; k < 2; ++k) dst[m][k] = *(const LAS bf16x8*)(lds + PG8_SA(b, h) + aoff + m * 2048 + k * 1024); } while (0)
#define PG8_LDB(dst, b, h) do { _Pragma("unroll") for (int n = 0; n < 2; ++n) _Pragma("unroll") for (int k = 0; k < 2; ++k) dst[n][k] = *(const LAS bf16x8*)(lds + PG8_SB(b, h) + boff + n * 2048 + k * 1024); } while (0)
#define PG8_MMA(ai, bj, At, Bt) do { __builtin_amdgcn_s_setprio(1); _Pragma("unroll") for (int m = 0; m < 4; ++m) _Pragma("unroll") for (int n = 0; n < 2; ++n) _Pragma("unroll") for (int k = 0; k < 2; ++k) \
        acc[ai][bj][m][n] = __builtin_amdgcn_mfma_f32_16x16x32_bf16(Bt[n][k], At[m][k], acc[ai][bj][m][n], 0, 0, 0); __builtin_amdgcn_s_setprio(0); } while (0)
#define PG8_WAIT_V(n) asm volatile("s_waitcnt vmcnt(" #n ")" ::: "memory")
#define PG8_WAIT_L(n) asm volatile("s_waitcnt lgkmcnt(" #n ")" ::: "memory")
#define PG8_BAR __builtin_amdgcn_s_barrier()
#define PG8_SCHED __builtin_amdgcn_sched_barrier(0)
#define PG8_UA(u) ((const char*)g.A + (size_t)(u).pm * tstepA + (size_t)(u).h0 * hstepA + (size_t)(((u).pn >> g.a_shift) * g.a_goff) * 2)
#define PG8_HA(u) ((!HALVES || (u).nh == 2) ? hstepA : 0u)
#define PG8_UB(u) ((const char*)g.Bt + (size_t)(u).pn * tstepB)
    Unit cur, nxt; int ui = 0;
    if (!S.next(0, cur)) return;
    f32x4 acc[2][2][4][2];
#pragma unroll
    for (int a = 0; a < 2; ++a)
#pragma unroll
        for (int b = 0; b < 2; ++b)
#pragma unroll
            for (int m = 0; m < 4; ++m)
#pragma unroll
                for (int n = 0; n < 2; ++n) acc[a][b][m][n] = (f32x4){0.f, 0.f, 0.f, 0.f};
    bf16x8 At[4][2], B0[2][2], B1[2][2];
    const char* cA = PG8_UA(cur); const char* cB = PG8_UB(cur); unsigned cHA = PG8_HA(cur);
    PG8_STAGE(PG8_SB(0, 0), cB, voffB); PG8_STAGE(PG8_SB(0, 1), cB + hstepB, voffB); PG8_STAGE(PG8_SA(0, 0), cA, voffA); PG8_STAGE(PG8_SA(0, 1), cA + cHA, voffA);
    if (wr == 1) PG8_BAR;
    PG8_WAIT_V(2); PG8_BAR;
    PG8_STAGE(PG8_SB(1, 0), cB + kstep, voffB); PG8_STAGE(PG8_SA(1, 0), cA + kstep, voffA); PG8_STAGE(PG8_SB(1, 1), cB + hstepB + kstep, voffB);
    PG8_WAIT_V(6); PG8_BAR;
    for (;;) {
        const bool has_next = S.next(ui + 1, nxt);
        const char* nA = has_next ? PG8_UA(nxt) : cA; const char* nB = has_next ? PG8_UB(nxt) : cB; const unsigned nHA = has_next ? PG8_HA(nxt) : cHA; const bool full = !HALVES || cur.nh == 2;
#define PG8_KLOOP(FULLC) _Pragma("unroll 1") for (int t = 0; t < nt; t += 2) { \
            const bool last = (t == nt - 2); \
            const char* a1 = cA + (size_t)(t + 1) * kstep; \
            const char* a2 = last ? nA : cA + (size_t)(t + 2) * kstep; const char* b2 = last ? nB : cB + (size_t)(t + 2) * kstep; \
            const char* a3 = a2 + kstep; const char* b3 = b2 + kstep; const unsigned h2 = last ? nHA : cHA; \
            PG8_LDB(B0, 0, 0); PG8_LDB(B1, 0, 1); PG8_SCHED; PG8_LDA(At, 0, 0); PG8_STAGE(PG8_SA(1, 1), a1 + cHA, voffA); \
            PG8_WAIT_V(8); PG8_WAIT_L(0); PG8_BAR; PG8_MMA(0, 0, At, B0); PG8_MMA(0, 1, At, B1); PG8_BAR; PG8_SCHED; \
            if (FULLC) PG8_LDA(At, 0, 1); PG8_STAGE(PG8_SB(0, 0), b2, voffB); PG8_STAGE(PG8_SB(0, 1), b2 + hstepB, voffB); PG8_STAGE(PG8_SA(0, 0), a2, voffA); \
            PG8_WAIT_V(8); PG8_WAIT_L(0); PG8_BAR; if (FULLC) { PG8_MMA(1, 0, At, B0); PG8_MMA(1, 1, At, B1); } PG8_BAR; PG8_SCHED; \
            PG8_LDB(B0, 1, 0); PG8_LDB(B1, 1, 1); PG8_SCHED; PG8_LDA(At, 1, 0); PG8_STAGE(PG8_SA(0, 1), a2 + h2, voffA); \
            PG8_WAIT_V(8); PG8_WAIT_L(0); PG8_BAR; PG8_MMA(0, 0, At, B0); PG8_MMA(0, 1, At, B1); PG8_BAR; PG8_SCHED; \
            if (FULLC) PG8_LDA(At, 1, 1); PG8_STAGE(PG8_SB(1, 0), b3, voffB); PG8_STAGE(PG8_SB(1, 1), b3 + hstepB, voffB); PG8_STAGE(PG8_SA(1, 0), a3, voffA); \
            PG8_WAIT_V(8); PG8_WAIT_L(0); PG8_BAR; if (FULLC) { PG8_MMA(1, 0, At, B0); PG8_MMA(1, 1, At, B1); } PG8_BAR; PG8_SCHED; \
        }
        if (full) { PG8_KLOOP(true) } else { PG8_KLOOP(false) }
#undef PG8_KLOOP
        if (wr == 0) PG8_BAR;
        E(acc, cur, wr, wc, fr, fq);
        if (!has_next) break;
#pragma unroll
        for (int a = 0; a < 2; ++a)
#pragma unroll
            for (int b = 0; b < 2; ++b)
#pragma unroll
                for (int m = 0; m < 4; ++m)
#pragma unroll
                    for (int n = 0; n < 2; ++n) acc[a][b][m][n] = (f32x4){0.f, 0.f, 0.f, 0.f};
        cur = nxt; cA = nA; cB = nB; cHA = nHA; ++ui;
        if (wr == 1) PG8_BAR;
    }
    PG8_WAIT_V(0);
    PG8_BAR;
#undef PG8_SA
#undef PG8_SB
#undef PG8_STAGE
#undef PG8_LDA
#undef PG8_LDB
#undef PG8_MMA
#undef PG8_WAIT_V
#undef PG8_WAIT_L
#undef PG8_BAR
#undef PG8_SCHED
#undef PG8_UA
#undef PG8_HA
#undef PG8_UB
}
}

__device__ __forceinline__ unsigned cvt_pk_bf16(float lo, float hi) { unsigned r; asm volatile("v_cvt_pk_bf16_f32 %0, %1, %2" : "=v"(r) : "v"(lo), "v"(hi)); return r; }
__device__ __forceinline__ u32x4 pack8(f32x4 a, f32x4 b) { u32x4 w; w.x = cvt_pk_bf16(a[0], a[1]); w.y = cvt_pk_bf16(a[2], a[3]); w.z = cvt_pk_bf16(b[0], b[1]); w.w = cvt_pk_bf16(b[2], b[3]); return w; }
__device__ __forceinline__ float bf_lo(unsigned w) { return __uint_as_float(w << 16); }
__device__ __forceinline__ float bf_hi(unsigned w) { return __uint_as_float(w & 0xffff0000u); }
__device__ __forceinline__ void unpack8(u32x4 w, f32x4& a, f32x4& b) { a = (f32x4){bf_lo(w.x), bf_hi(w.x), bf_lo(w.y), bf_hi(w.y)}; b = (f32x4){bf_lo(w.z), bf_hi(w.z), bf_lo(w.w), bf_hi(w.w)}; }
__device__ __forceinline__ float frcp(float x) { return __builtin_amdgcn_rcpf(x); }
__device__ __forceinline__ float fexp(float x) { return __builtin_amdgcn_exp2f(x * 1.4426950408889634f); }
__device__ __forceinline__ float sigmoidf_(float x) { return frcp(1.0f + fexp(-x)); }
__device__ __forceinline__ float gelu_tanh(float x) { const float z = 0.7978845608028654f * (x + 0.044715f * x * x * x); return x * frcp(1.0f + fexp(-2.0f * z)); }
__device__ __forceinline__ float silu_(float x) { return x * frcp(1.0f + fexp(-x)); }
__device__ __forceinline__ float wave_sum(float v) {
#pragma unroll
    for (int o = 1; o < 64; o <<= 1) v += __shfl_xor(v, o);
    return v;
}

typedef f32x4 Acc[2][2][4][2];
__device__ __forceinline__ int fresh_lane() { int l; asm volatile("v_mbcnt_lo_u32_b32 %0, -1, 0\n\tv_mbcnt_hi_u32_b32 %0, -1, %0" : "=v"(l)); return l; }
#define EPI_LANES() const int l_ = fresh_lane(); const int fr = l_ & 15, fq = l_ >> 4; (void)fr_; (void)fq_
struct RopeRow { f32x4 c0, c1, s0, s1; };
__device__ __forceinline__ RopeRow rope_load(const float* rope, int t) { RopeRow r; r.c0 = *(const f32x4*)(rope + t * 16); r.c1 = *(const f32x4*)(rope + t * 16 + 4); r.s0 = *(const f32x4*)(rope + t * 16 + 8); r.s1 = *(const f32x4*)(rope + t * 16 + 12); return r; }
__device__ __forceinline__ void rope8(f32x4& v0, f32x4& v1, const RopeRow& rr, int fq) {
    f32x4 p0, p1;
#pragma unroll
    for (int e = 0; e < 4; ++e) { p0[e] = __shfl_xor(v0[e], 16); p1[e] = __shfl_xor(v1[e], 16); }
    if (fq == 0) { v0 = v0 * rr.c0 - p0 * rr.s0; v1 = v1 * rr.c1 - p1 * rr.s1; }
    else if (fq == 1) { v0 = v0 * rr.c0 + p0 * rr.s0; v1 = v1 * rr.c1 + p1 * rr.s1; }
}

struct EpiProj0 {
    const float* ss; const float* rope; bf16_t *xbr, *yg, *q, *k, *v;
    __device__ __forceinline__ void operator()(const Acc& acc, const pg8::Unit& u, int wr, int wc, int fr_, int fq_) const {
        EPI_LANES();
        const int row0 = u.pm * 256 + u.h0 * 128 + wr * 64 + fr, colw = wc * 32 + 8 * fq, pn = u.pn;
        bf16_t* dst; int ld, cb;
        if (pn < 4) { dst = xbr; ld = 1024; cb = pn * 256; }
        else if (pn < 8) { dst = yg; ld = 1024; cb = (pn - 4) * 256; }
        else { const int t3 = (pn - 8) >> 1; dst = q + (size_t)t3 * 8388608;     ld = 512; cb = ((pn - 8) & 1) * 256; }
        const bool do_gelu = (pn >= 4 && pn < 8), do_rope = (pn >= 8 && pn < 12 && (wc & 1) == 0);
        float ssv[2][4];
#pragma unroll
        for (int ai = 0; ai < 2; ++ai)
#pragma unroll
            for (int m = 0; m < 4; ++m) ssv[ai][m] = ss[row0 + ai * 128 + m * 16];
#pragma unroll
        for (int ai = 0; ai < 2; ++ai) if (ai < u.nh)
#pragma unroll
            for (int m = 0; m < 4; ++m) { const int row = row0 + ai * 128 + m * 16; const float rinv = rsqrtf(ssv[ai][m] * (1.0f / DM) + EPS);
                RopeRow rr; if (do_rope) rr = rope_load(rope, row & (SEQ - 1));
#pragma unroll
                for (int bj = 0; bj < 2; ++bj) { f32x4 v0 = acc[ai][bj][m][0] * rinv, v1 = acc[ai][bj][m][1] * rinv;
                    if (do_gelu) {
#pragma unroll
                        for (int e = 0; e < 4; ++e) { v0[e] = gelu_tanh(v0[e]); v1[e] = gelu_tanh(v1[e]); } }
                    if (do_rope) rope8(v0, v1, rr, fq);
                    *(u32x4*)(dst + (size_t)row * ld + cb + bj * 128 + colw) = pack8(v0, v1); } }
    }
};
struct EpiGates {
    const bf16_t* xc; const float *ba, *bx, *lam; bf16_t *la, *uo;
    __device__ __forceinline__ void operator()(const Acc& acc, const pg8::Unit& u, int wr, int wc, int fr_, int fq_) const {
        EPI_LANES();
        const int row0 = u.pm * 256 + u.h0 * 128 + wr * 64 + fr, ch = (u.pn >> 1) * 256 + (u.pn & 1) * 128 + wc * 32 + 8 * fq;
        f32x4 nsp[2], bav[2], bxv[2];
#pragma unroll
        for (int n = 0; n < 2; ++n) { const f32x4 lm = *(const f32x4*)(lam + ch + 4 * n); bav[n] = *(const f32x4*)(ba + ch + 4 * n); bxv[n] = *(const f32x4*)(bx + ch + 4 * n);
#pragma unroll
            for (int e = 0; e < 4; ++e) { const float x = fexp(-lm[e]); nsp[n][e] = -8.0f * (x * (1.0f - x * (0.5f - x * (0.3333333333f - 0.25f * x)))); } }
        u32x4 xws[2][4];
#pragma unroll
        for (int ai = 0; ai < 2; ++ai)
#pragma unroll
            for (int m = 0; m < 4; ++m) xws[ai][m] = *(const u32x4*)(xc + (size_t)(row0 + ai * 128 + m * 16) * 1024 + ch);
#pragma unroll
        for (int ai = 0; ai < 2; ++ai) if (ai < u.nh)
#pragma unroll
            for (int m = 0; m < 4; ++m) { const size_t off = (size_t)(row0 + ai * 128 + m * 16) * 1024 + ch;
                f32x4 x[2], lg[2], uu[2]; unpack8(xws[ai][m], x[0], x[1]);
#pragma unroll
                for (int n = 0; n < 2; ++n)
#pragma unroll
                    for (int e = 0; e < 4; ++e) { const float r = sigmoidf_(acc[ai][0][m][n][e] + bav[n][e]), ig = sigmoidf_(acc[ai][1][m][n][e] + bxv[n][e]); lg[n][e] = nsp[n][e] * r;
                        uu[n][e] = __builtin_amdgcn_sqrtf(fmaxf(1.0f - fexp(2.0f * lg[n][e]), 0.f)) * ig * x[n][e]; }
                *(u32x4*)(la + off) = pack8(lg[0], lg[1]); *(u32x4*)(uo + off) = pack8(uu[0], uu[1]); }
    }
};
template <bool BASE_F32, bool OUT_F32>
struct EpiResid {
    const float* basef; const bf16_t* baseh; float* outf; bf16_t* h16; const float* bias; float* ssn;
    __device__ __forceinline__ void operator()(const Acc& acc, const pg8::Unit& u, int wr, int wc, int fr_, int fq_) const {
        EPI_LANES();
        const int row0 = u.pm * 256 + u.h0 * 128 + wr * 64 + fr, col0 = u.pn * 256 + wc * 32 + 8 * fq;
        f32x4 bv[2][2];
#pragma unroll
        for (int bj = 0; bj < 2; ++bj)
#pragma unroll
            for (int n = 0; n < 2; ++n) bv[bj][n] = bias ? *(const f32x4*)(bias + col0 + bj * 128 + 4 * n) : (f32x4){0.f, 0.f, 0.f, 0.f};
        u32x4 bb[4][2];
        if (!BASE_F32) {
#pragma unroll
            for (int m = 0; m < 4; ++m)
#pragma unroll
                for (int bj = 0; bj < 2; ++bj) bb[m][bj] = *(const u32x4*)(baseh + (size_t)(row0 + m * 16) * DM + col0 + bj * 128);
        }
#pragma unroll
        for (int ai = 0; ai < 2; ++ai) if (ai < u.nh)
#pragma unroll
            for (int m = 0; m < 4; ++m) { const int row = row0 + ai * 128 + m * 16; float sq = 0.f;
#pragma unroll
                for (int bj = 0; bj < 2; ++bj) { const size_t off = (size_t)row * DM + col0 + bj * 128;
                    f32x4 b0, b1;
                    if (BASE_F32) { b0 = *(const f32x4*)(basef + off); b1 = *(const f32x4*)(basef + off + 4); } else { unpack8(bb[m][bj], b0, b1); if (ai == 0 && u.nh == 2) bb[m][bj] = *(const u32x4*)(baseh + off + (size_t)128 * DM); }
                    const f32x4 v0 = acc[ai][bj][m][0] + bv[bj][0] + b0, v1 = acc[ai][bj][m][1] + bv[bj][1] + b1;
                    if (OUT_F32) { *(f32x4*)(outf + off) = v0; *(f32x4*)(outf + off + 4) = v1; } else *(u32x4*)(h16 + off) = pack8(v0, v1);
                    sq += (v0[0] * v0[0] + v0[1] * v0[1]) + (v0[2] * v0[2] + v0[3] * v0[3]) + (v1[0] * v1[0] + v1[1] * v1[1]) + (v1[2] * v1[2] + v1[3] * v1[3]); }
                sq += __shfl_xor(sq, 16); sq += __shfl_xor(sq, 32);
                if (fq == 0) atomicAdd(ssn + row, sq); if (BASE_F32) asm volatile("" ::: "memory"); }
    }
};
struct EpiFinal {
    const bf16_t* baseh; float* out; const float* gain; float* ssn; unsigned* cnt;
    __device__ __forceinline__ void operator()(Acc& acc, const pg8::Unit& u, int wr, int wc, int fr_, int fq_) const {
        EPI_LANES();
        const int row0 = u.pm * 256 + u.h0 * 128 + wr * 64 + fr, col0 = u.pn * 256 + wc * 32 + 8 * fq;
        u32x4 bb[4][2];
#pragma unroll
        for (int m = 0; m < 4; ++m)
#pragma unroll
            for (int bj = 0; bj < 2; ++bj) bb[m][bj] = *(const u32x4*)(baseh + (size_t)(row0 + m * 16) * DM + col0 + bj * 128);
#pragma unroll
        for (int ai = 0; ai < 2; ++ai) if (ai < u.nh)
#pragma unroll
            for (int m = 0; m < 4; ++m) { const int row = row0 + ai * 128 + m * 16; float sq = 0.f;
#pragma unroll
                for (int bj = 0; bj < 2; ++bj) { f32x4 b0, b1; unpack8(bb[m][bj], b0, b1); if (ai == 0) bb[m][bj] = *(const u32x4*)(baseh + (size_t)(row0 + 128 + m * 16) * DM + col0 + bj * 128);
                    const f32x4 v0 = acc[ai][bj][m][0] + b0, v1 = acc[ai][bj][m][1] + b1; acc[ai][bj][m][0] = v0; acc[ai][bj][m][1] = v1;
                    sq += (v0[0] * v0[0] + v0[1] * v0[1]) + (v0[2] * v0[2] + v0[3] * v0[3]) + (v1[0] * v1[0] + v1[1] * v1[1]) + (v1[2] * v1[2] + v1[3] * v1[3]); }
                sq += __shfl_xor(sq, 16); sq += __shfl_xor(sq, 32);
                if (fq == 0) atomicAdd(ssn + row, sq); }
        asm volatile("s_waitcnt vmcnt(0)" ::: "memory");
        __syncthreads();
        if (threadIdx.x == 0) { unsigned* c = cnt + 64 * u.pm;
            __hip_atomic_fetch_add(c, 1u, __ATOMIC_RELAXED, __HIP_MEMORY_SCOPE_AGENT);
            unsigned sp = 0; while (__hip_atomic_load(c, __ATOMIC_RELAXED, __HIP_MEMORY_SCOPE_AGENT) < 4u) { __builtin_amdgcn_s_sleep(1); if (++sp > (1u << 20)) break; } }
        __syncthreads();
        f32x4 gv[2][2];
#pragma unroll
        for (int bj = 0; bj < 2; ++bj)
#pragma unroll
            for (int n = 0; n < 2; ++n) gv[bj][n] = *(const f32x4*)(gain + col0 + bj * 128 + 4 * n);
#pragma unroll
        for (int ai = 0; ai < 2; ++ai) if (ai < u.nh)
#pragma unroll
            for (int m = 0; m < 4; ++m) { const int row = row0 + ai * 128 + m * 16;
                const float rinv = rsqrtf(__hip_atomic_load(ssn + row, __ATOMIC_RELAXED, __HIP_MEMORY_SCOPE_AGENT) * (1.0f / DM) + EPS);
#pragma unroll
                for (int bj = 0; bj < 2; ++bj) { const size_t off = (size_t)row * DM + col0 + bj * 128;
                    *(f32x4*)(out + off) = acc[ai][bj][m][0] * rinv * gv[bj][0]; *(f32x4*)(out + off + 4) = acc[ai][bj][m][1] * rinv * gv[bj][1]; } }
    }
};
struct EpiScale {
    const float* ss; bf16_t* out; int ldc;
    __device__ __forceinline__ void operator()(const Acc& acc, const pg8::Unit& u, int wr, int wc, int fr_, int fq_) const {
        EPI_LANES();
        const int row0 = u.pm * 256 + u.h0 * 128 + wr * 64 + fr, col0 = u.pn * 256 + wc * 32 + 8 * fq;
        float ssv[2][4];
#pragma unroll
        for (int ai = 0; ai < 2; ++ai)
#pragma unroll
            for (int m = 0; m < 4; ++m) ssv[ai][m] = ss[row0 + ai * 128 + m * 16];
#pragma unroll
        for (int ai = 0; ai < 2; ++ai) if (ai < u.nh)
#pragma unroll
            for (int m = 0; m < 4; ++m) { const int row = row0 + ai * 128 + m * 16; const float rinv = rsqrtf(ssv[ai][m] * (1.0f / DM) + EPS);
#pragma unroll
                for (int bj = 0; bj < 2; ++bj) *(u32x4*)(out + (size_t)row * ldc + col0 + bj * 128) = pack8(acc[ai][bj][m][0] * rinv, acc[ai][bj][m][1] * rinv); }
    }
};
struct EpiSwiglu {
    const float* ss; bf16_t* out;
    __device__ __forceinline__ void operator()(const Acc& acc, const pg8::Unit& u, int wr, int wc, int fr_, int fq_) const {
        EPI_LANES();
        const int row0 = u.pm * 256 + u.h0 * 128 + wr * 64 + fr, col0 = u.pn * 128 + wc * 32 + 8 * fq;
        float ssv[2][4];
#pragma unroll
        for (int ai = 0; ai < 2; ++ai)
#pragma unroll
            for (int m = 0; m < 4; ++m) ssv[ai][m] = ss[row0 + ai * 128 + m * 16];
#pragma unroll
        for (int ai = 0; ai < 2; ++ai) if (ai < u.nh)
#pragma unroll
            for (int m = 0; m < 4; ++m) { const int row = row0 + ai * 128 + m * 16; const float rinv = rsqrtf(ssv[ai][m] * (1.0f / DM) + EPS);
                f32x4 o0, o1;
#pragma unroll
                for (int e = 0; e < 4; ++e) { o0[e] = silu_(acc[ai][0][m][0][e] * rinv) * (acc[ai][1][m][0][e] * rinv); o1[e] = silu_(acc[ai][0][m][1][e] * rinv) * (acc[ai][1][m][1][e] * rinv); }
                *(u32x4*)(out + (size_t)row * DFF + col0) = pack8(o0, o1); }
    }
};
struct EpiQkv1 {
    const float* ss; const float* rope; const float* bias; bf16_t *q, *kv;
    __device__ __forceinline__ void operator()(const Acc& acc, const pg8::Unit& u, int wr, int wc, int fr_, int fq_) const {
        EPI_LANES();
        const int row0 = u.pm * 256 + u.h0 * 128 + wr * 64 + fr, colw = wc * 32 + 8 * fq, pn = u.pn;
        bf16_t* dst = pn < 4 ? q : kv; const int ld = pn < 4 ? 1024 : 256, cb = pn < 4 ? pn * 256 : 0;
        f32x4 bv[2][2];
#pragma unroll
        for (int bj = 0; bj < 2; ++bj)
#pragma unroll
            for (int n = 0; n < 2; ++n) bv[bj][n] = *(const f32x4*)(bias + pn * 256 + bj * 128 + colw + 4 * n);
        float ssv[2][4];
#pragma unroll
        for (int ai = 0; ai < 2; ++ai)
#pragma unroll
            for (int m = 0; m < 4; ++m) ssv[ai][m] = ss[row0 + ai * 128 + m * 16];
#pragma unroll
        for (int ai = 0; ai < 2; ++ai) if (ai < u.nh)
#pragma unroll
            for (int m = 0; m < 4; ++m) { const int row = row0 + ai * 128 + m * 16; const float rinv = rsqrtf(ssv[ai][m] * (1.0f / DM) + EPS);
                RopeRow rr; if ((wc & 1) == 0) rr = rope_load(rope, row & (SEQ - 1));
#pragma unroll
                for (int bj = 0; bj < 2; ++bj) { f32x4 v0 = acc[ai][bj][m][0] * rinv + bv[bj][0], v1 = acc[ai][bj][m][1] * rinv + bv[bj][1];
                    if ((wc & 1) == 0 && (pn < 4 || bj == 0)) rope8(v0, v1, rr, fq);
                    *(u32x4*)(dst + (size_t)row * ld + cb + bj * 128 + colw) = pack8(v0, v1); } }
    }
};

struct AU { const bf16_t *Qp, *Kp, *Vp; bf16_t* Op; float* lsep; long qstride, kstride, vstride, ostride, lsestride; int hasprev, maxd, has_sink; float sink; int kvkey; };
typedef short v4i16_t __attribute__((ext_vector_type(4)));
template <int HD, int MODE, int RT, class Dec>
__device__ __forceinline__ void attn_phase(LAS unsigned char* lds, const Dec& dec, int nunits, float scale) {
    constexpr int QW = 16 * RT, NK = MODE == 0 ? 128 + 128 * RT : 256;
    constexpr int PPR = HD / 8, KP = HD + 8, VPI = (HD == 64 ? 72 : 144), NIT = NK * PPR / 512;
    constexpr int NCH = MODE == 0 ? 5 : 8, NT = 2 * NCH, NC = HD / 32, NDT = HD / 16;
    static_assert((MODE == 1 && RT == 1) || (MODE == 0 && RT == 2), "dense mode: one row tile per wave; banded mode: two (the compile-time tile classes assume the 32-aligned window)");
    const int lane = fresh_lane(), w = __builtin_amdgcn_readfirstlane(threadIdx.x >> 6), tid = w * 64 + lane, l15 = lane & 15, quad = lane >> 4;
    LAS bf16_t* Kl = (LAS bf16_t*)lds; LAS bf16_t* Vl = Kl + NK * KP;
    const int G = gridDim.x;
    int u = (G % 8 == 0) ? (int)(blockIdx.x % 8) * (G / 8) + (int)(blockIdx.x / 8) : (int)blockIdx.x;
    if (u >= nunits) return;
    const int qq0 = QW * w + l15;
    AU cur; dec(u, cur);
    u32x4 kv[NIT], vv[NIT]; bf16x8 qf[RT][NC];
#define AT_LOADKV(au) do { _Pragma("unroll") for (int it = 0; it < NIT; ++it) { const int p = it * 512 + tid, key = p / PPR, part = p % PPR; const int ks = (MODE == 0 && !(au).hasprev && key < 128) ? key + 128 : key; \
        kv[it] = *(const u32x4*)((au).Kp + (long)ks * (au).kstride + part * 8); vv[it] = *(const u32x4*)((au).Vp + (long)ks * (au).vstride + part * 8); } } while (0)
#define AT_LOADQ(au, dst) do { _Pragma("unroll") for (int rt = 0; rt < RT; ++rt) _Pragma("unroll") for (int c = 0; c < NC; ++c) dst[rt][c] = *(const bf16x8*)((au).Qp + (long)(qq0 + 16 * rt) * (au).qstride + 32 * c + quad * 8); } while (0)
    constexpr bool PF = (HD == 64);
    if (PF) AT_LOADKV(cur);
    AT_LOADQ(cur, qf);
    bool need_stage = true;
    for (;;) {
        if (need_stage) {
            if (!PF) AT_LOADKV(cur);
#pragma unroll
            for (int it = 0; it < NIT; ++it) { const int p = it * 512 + tid, key = p / PPR, part = p % PPR;
                *(LAS u32x4*)(Kl + key * KP + part * 8) = kv[it]; *(LAS u32x4*)(Vl + key * VPI + part * 8) = vv[it]; }
        }
        __syncthreads();
        const int un = u + G; const bool has_next = un < nunits; AU nxt = cur; bool next_stage = false; bf16x8 qn[RT][NC];
#pragma unroll
        for (int rt = 0; rt < RT; ++rt)
#pragma unroll
            for (int c = 0; c < NC; ++c) qn[rt][c] = qf[rt][c];
        if (has_next) { dec(un, nxt); next_stage = nxt.kvkey != cur.kvkey; if (PF && next_stage) AT_LOADKV(nxt); AT_LOADQ(nxt, qn); }
        const int ch0 = MODE == 0 ? (RT == 2 ? w : (w >> 1)) : 0;
        const float cexp = scale * 1.4426950408889634f;
        f32x4 s[RT][NT];
        float mx[RT];
#pragma unroll
        for (int rt = 0; rt < RT; ++rt) mx[rt] = -3.0e38f;
#pragma unroll
        for (int t = 0; t < NT; ++t) {
            const int kmin = ch0 * 32 + 16 * t; const int kr = kmin + l15;
            const bool dead = MODE == 0 && !cur.hasprev && kmin < 128;
            if (!dead) {
                bf16x8 kf[NC];
#pragma unroll
                for (int c = 0; c < NC; ++c) kf[c] = *(const LAS bf16x8*)(Kl + kr * KP + 32 * c + quad * 8);
#pragma unroll
                for (int rt = 0; rt < RT; ++rt) { const int d = t - rt;
                    if (MODE == 0 && (d < 0 || d > 8)) { s[rt][t] = (f32x4){-1.0e30f, -1.0e30f, -1.0e30f, -1.0e30f}; }
                    else {
                        s[rt][t] = (f32x4){0.f, 0.f, 0.f, 0.f};
#pragma unroll
                        for (int c = 0; c < NC; ++c) s[rt][t] = __builtin_amdgcn_mfma_f32_16x16x32_bf16(kf[c], qf[rt][c], s[rt][t], 0, 0, 0);
                        if (MODE == 0 && (d == 0 || d == 8)) { const int qq = qq0 + 16 * rt;
#pragma unroll
                            for (int jj = 0; jj < 4; ++jj) { const int dist = 128 + qq - (kmin + quad * 4 + jj); s[rt][t][jj] = (dist >= 0 && dist <= cur.maxd) ? s[rt][t][jj] : -1.0e30f; } }
                        mx[rt] = fmaxf(fmaxf(mx[rt], fmaxf(s[rt][t][0], s[rt][t][1])), fmaxf(s[rt][t][2], s[rt][t][3]));
                    }
                }
            } else {
#pragma unroll
                for (int rt = 0; rt < RT; ++rt) s[rt][t] = (f32x4){-1.0e30f, -1.0e30f, -1.0e30f, -1.0e30f};
            }
        }
        float mnat[RT], lsum[RT];
#pragma unroll
        for (int rt = 0; rt < RT; ++rt) {
            float m_ = mx[rt]; m_ = fmaxf(m_, __shfl_xor(m_, 16)); m_ = fmaxf(m_, __shfl_xor(m_, 32));
            float mn = m_ * scale;
            if (cur.has_sink) mn = fmaxf(mn, cur.sink);
            const float moff = -mn * 1.4426950408889634f;
            float ls = 0.f;
#pragma unroll
            for (int t = 0; t < NT; ++t)
#pragma unroll
                for (int jj = 0; jj < 4; ++jj) { const float p = __builtin_amdgcn_exp2f(__builtin_fmaf(s[rt][t][jj], cexp, moff)); s[rt][t][jj] = p; ls += p; }
            ls += __shfl_xor(ls, 16); ls += __shfl_xor(ls, 32);
            if (cur.has_sink) ls += __expf(cur.sink - mn);
            mnat[rt] = mn; lsum[rt] = ls;
        }
        f32x4 o[RT][NDT];
#pragma unroll
        for (int rt = 0; rt < RT; ++rt)
#pragma unroll
            for (int dt = 0; dt < NDT; ++dt) o[rt][dt] = (f32x4){0.f, 0.f, 0.f, 0.f};
#pragma unroll
        for (int c = 0; c < NCH; ++c) { bf16x8 pf[RT];
#pragma unroll
            for (int rt = 0; rt < RT; ++rt) { const u32x4 pw = pack8(s[rt][2 * c], s[rt][2 * c + 1]); pf[rt] = __builtin_bit_cast(bf16x8, pw); }
            const LAS bf16_t* vb = Vl + ((ch0 + c) * 32 + quad * 4 + (l15 >> 2)) * VPI + 4 * (l15 & 3);
#pragma unroll
            for (int dt = 0; dt < NDT; ++dt) {
                const v4i16_t lo = __builtin_amdgcn_ds_read_tr16_b64_v4i16((LAS v4i16_t*)(vb + 16 * dt)), hi = __builtin_amdgcn_ds_read_tr16_b64_v4i16((LAS v4i16_t*)(vb + 16 * VPI + 16 * dt));
                const bf16x8 vf = (bf16x8){lo[0], lo[1], lo[2], lo[3], hi[0], hi[1], hi[2], hi[3]};
#pragma unroll
                for (int rt = 0; rt < RT; ++rt) o[rt][dt] = __builtin_amdgcn_mfma_f32_16x16x32_bf16(vf, pf[rt], o[rt][dt], 0, 0, 0); } }
#pragma unroll
        for (int rt = 0; rt < RT; ++rt) { const int qq = qq0 + 16 * rt;
            const float inv = frcp(lsum[rt]);
            bf16_t* orow = cur.Op + (long)qq * cur.ostride + quad * 4;
#pragma unroll
            for (int dt = 0; dt < NDT; ++dt) { u32x2 ow; ow.x = cvt_pk_bf16(o[rt][dt][0] * inv, o[rt][dt][1] * inv); ow.y = cvt_pk_bf16(o[rt][dt][2] * inv, o[rt][dt][3] * inv); *(u32x2*)(orow + 16 * dt) = ow; }
            if (cur.lsep && quad == 0) cur.lsep[(long)qq * cur.lsestride] = mnat[rt] + __logf(lsum[rt]); }
        __syncthreads();
        if (!has_next) break;
        cur = nxt; u = un; need_stage = next_stage;
#pragma unroll
        for (int rt = 0; rt < RT; ++rt)
#pragma unroll
            for (int c = 0; c < NC; ++c) qf[rt][c] = qn[rt][c];
    }
#undef AT_LOADKV
#undef AT_LOADQ
}
struct DecL0 {
    const bf16_t *q, *k, *v; bf16_t* ob; float* lse;
    __device__ __forceinline__ void operator()(int u, AU& a) const {
        const int i = u >> 8, uv = u & 255, x = uv >> 5, cl = uv & 31, br = i % 3, bh = x * 4 + (i / 3) * 2 + (cl >> 4), b = bh >> 3, h = bh & 7, blk2 = cl & 15;
        const int dd = br == 0 ? 1 : (br == 1 ? 4 : 16), nbk2 = 16 / dd, r = blk2 / nbk2, jp = blk2 % nbk2;
        const long rowq = (long)b * SEQ + (long)jp * 256 * dd + r, rowk = rowq - 128 * dd;
        a.Qp = q + rowq * 512 + h * 64; a.Kp = k + rowk * 512 + h * 64; a.Vp = v + rowk * 512 + h * 64; a.Op = ob + (size_t)br * M * 512 + rowq * 512 + h * 64; a.lsep = lse + (size_t)br * M * 8 + rowq * 8 + h;
        a.qstride = a.kstride = a.vstride = a.ostride = (long)dd * 512; a.lsestride = (long)dd * 8; a.hasprev = jp > 0; a.maxd = 128; a.has_sink = 0; a.sink = 0.f; a.kvkey = u;
    }
};
struct DecL1 {
    const bf16_t *q, *kv; bf16_t* o; const float* sinks;
    __device__ __forceinline__ void operator()(int u, AU& a) const {
        const int g = u >> 7, rest = u & 127, b = rest >> 5, kvh = (rest >> 4) & 1, jp = rest & 15, hq = kvh * 8 + g;
        const long rowq = (long)b * SEQ + jp * 256, rowk = rowq - 128;
        a.Qp = q + rowq * 1024 + hq * 64; a.Kp = kv + rowk * 256 + kvh * 64; a.Vp = kv + rowk * 256 + 128 + kvh * 64; a.Op = o + rowq * 1024 + hq * 64; a.lsep = nullptr;
        a.qstride = 1024; a.kstride = a.vstride = 256; a.ostride = 1024; a.lsestride = 0; a.hasprev = jp > 0; a.maxd = 127; a.has_sink = 1; a.sink = sinks[hq]; a.kvkey = rest;
    }
};
struct DecXA {
    const bf16_t *xq, *mkv; bf16_t* xo;
    __device__ __forceinline__ void operator()(int u, AU& a) const {
        const int i = u >> 8, rest = u & 255, b = rest >> 6, h = (rest >> 4) & 3, jb = (rest & 15) * 2 + i;
        const long rowq = (long)b * SEQ + jb * 128;
        a.Qp = xq + rowq * 512 + h * 128; a.Kp = mkv + (size_t)b * 256 * 1024 + h * 128; a.Vp = a.Kp + 512; a.Op = xo + rowq * 512 + h * 128; a.lsep = nullptr;
        a.qstride = 512; a.kstride = a.vstride = 1024; a.ostride = 512; a.lsestride = 0; a.hasprev = 1; a.maxd = 0; a.has_sink = 0; a.sink = 0.f; a.kvkey = rest >> 4;
    }
};

__device__ __forceinline__ void tr_tile(const float* W, int N, const float* gain, bf16_t* WT, int ldt, int k0, int n0, int drow0, LAS float* scr, int lane) {
    const int n4 = (lane & 15) * 4, kq = lane >> 4;
    f32x4 v[16];
#pragma unroll
    for (int i = 0; i < 16; ++i) v[i] = *(const f32x4*)(W + (size_t)(k0 + 4 * i + kq) * N + n0 + n4);
    if (gain) {
#pragma unroll
        for (int i = 0; i < 16; ++i) v[i] = v[i] * gain[k0 + 4 * i + kq]; }
#pragma unroll
    for (int i = 0; i < 16; ++i) { LAS float* d = scr + (4 * i + kq) * 65 + n4; d[0] = v[i].x; d[1] = v[i].y; d[2] = v[i].z; d[3] = v[i].w; }
    asm volatile("s_waitcnt lgkmcnt(0)" ::: "memory");
    const int c = lane & 7;
#pragma unroll
    for (int j = 0; j < 8; ++j) { const int n = (lane >> 3) + 8 * j; const LAS float* s = scr + (8 * c) * 65 + n;
        u32x4 o; o.x = cvt_pk_bf16(s[0 * 65], s[1 * 65]); o.y = cvt_pk_bf16(s[2 * 65], s[3 * 65]); o.z = cvt_pk_bf16(s[4 * 65], s[5 * 65]); o.w = cvt_pk_bf16(s[6 * 65], s[7 * 65]);
        *(u32x4*)(WT + (size_t)(drow0 + n) * ldt + k0 + 8 * c) = o; }
    asm volatile("s_waitcnt lgkmcnt(0)" ::: "memory");
}
__device__ __forceinline__ void tr_plain(const float* W, int K, int N, const float* gain, bf16_t* WT, int item, LAS float* scr, int lane) {
    const int nblk = N / 64, kb = item / nblk, nb = item % nblk; tr_tile(W, N, gain, WT, K, 64 * kb, 64 * nb, 64 * nb, scr, lane);
}
__device__ __forceinline__ void row_to_bf16_ss(const float* xrow, bf16_t* orow, float* ssp, int lane) {
    const f32x4* xr = (const f32x4*)xrow + lane; f32x4 v[4]; float s = 0.f;
#pragma unroll
    for (int j = 0; j < 4; ++j) { v[j] = xr[64 * j]; s += (v[j].x * v[j].x + v[j].y * v[j].y) + (v[j].z * v[j].z + v[j].w * v[j].w); }
    s = wave_sum(s);
    u32x2* o8 = (u32x2*)orow + lane;
#pragma unroll
    for (int j = 0; j < 4; ++j) { u32x2 ow; ow.x = cvt_pk_bf16(v[j].x, v[j].y); ow.y = cvt_pk_bf16(v[j].z, v[j].w); o8[64 * j] = ow; }
    if (lane == 0) *ssp = s;
}

#define GAS __attribute__((address_space(1)))
struct Args { const GAS float* in[26]; GAS float* out; GAS unsigned char* ws; int ph_lo, ph_hi; };
constexpr int NPHASE = 21;

#define XB_TMO      128
#define XB_XCNT(j)  (256  + 64 * (j))
#define XB_XSUB(j)  (1280 + 64 * (j))
#define XB_XGEN(j)  (2304 + 64 * (j))
#define XB_TOP      3328
#define XB_TOPGEN   3392
#define XCD_BAR_WORDS 3456
#define XB_SPIN_CAP (1u << 18)
__device__ __forceinline__ unsigned xb_ld(unsigned* p)              { return __hip_atomic_load(p, __ATOMIC_RELAXED, __HIP_MEMORY_SCOPE_AGENT); }
__device__ __forceinline__ unsigned xb_add(unsigned* p, unsigned v) { return __hip_atomic_fetch_add(p, v, __ATOMIC_RELAXED, __HIP_MEMORY_SCOPE_AGENT); }
__device__ __forceinline__ unsigned xb_xcc_id() { return (unsigned)__builtin_amdgcn_s_getreg((3 << 11) | 20) & 0xFu; }
#define XB_SPIN(cond, bar) do { unsigned _sp = 0; while (cond) { __builtin_amdgcn_s_sleep(1); \
    if ((++_sp & 255u) == 0u) { if (xb_ld(&(bar)[XB_TMO])) break; if (_sp > XB_SPIN_CAP) { atomicAdd(&(bar)[XB_TMO], 1u); break; } } } } while (0)
struct XcdBarrier { unsigned* bar; unsigned x; volatile LAS unsigned* st; };
__device__ __forceinline__ XcdBarrier xcd_barrier_post(unsigned* bar, volatile LAS unsigned* st) {
    XcdBarrier b; b.bar = bar; b.x = xb_xcc_id(); b.st = st;
    if (threadIdx.x == 0) (void)xb_add(&bar[XB_XCNT(b.x)], 1u);
    return b;
}
__device__ __forceinline__ void xcd_barrier_complete(unsigned* bar, unsigned x, unsigned& nloc, unsigned& nx) {
    const unsigned G = gridDim.x * gridDim.y * gridDim.z;
    unsigned sum, cnt, mine, sp = 0u;
    for (;;) {
        sum = 0u; cnt = 0u; mine = 0u;
#pragma unroll
        for (unsigned j = 0; j < 16; ++j) { const unsigned c = xb_ld(&bar[XB_XCNT(j)]); sum += c; cnt += (c > 0u) ? 1u : 0u; mine = (j == x) ? c : mine; }
        if (sum == G) break;
        __builtin_amdgcn_s_sleep(1);
        if ((++sp & 255u) == 0u) { if (xb_ld(&bar[XB_TMO])) break; if (sp > XB_SPIN_CAP) { atomicAdd(&bar[XB_TMO], 1u); break; } }
    }
    nloc = mine > 0u ? mine : 1u; nx = cnt > 0u ? cnt : 1u;
}
__device__ __forceinline__ void xcd_barrier(const XcdBarrier& b) {
    asm volatile("s_waitcnt vmcnt(0)" ::: "memory");
    __syncthreads();
    if (threadIdx.x == 0) {
        unsigned* bar = b.bar;
        __builtin_amdgcn_s_waitcnt(0);
        asm volatile("buffer_inv sc1" ::: "memory");
        unsigned nloc = b.st[0], nx = b.st[1];
        if (nloc == 0u) { xcd_barrier_complete(bar, b.x, nloc, nx); b.st[0] = nloc; b.st[1] = nx; }
        const unsigned old = xb_add(&bar[XB_XSUB(b.x)], 1u);
        const unsigned gen = old / nloc;
        if (old + 1u == (gen + 1u) * nloc) {
            __builtin_amdgcn_fence(__ATOMIC_RELEASE, "agent");
            asm volatile("s_waitcnt vmcnt(0)" ::: "memory");
            const unsigned og = xb_add(&bar[XB_TOP], 1u);
            const unsigned tg = og / nx;
            if (og + 1u == (tg + 1u) * nx) xb_add(&bar[XB_TOPGEN], 1u);
            else XB_SPIN(xb_ld(&bar[XB_TOPGEN]) == tg, bar);
            asm volatile("s_waitcnt vmcnt(0)" ::: "memory");
        } else {
            XB_SPIN(xb_ld(&bar[XB_TOPGEN]) == gen, bar);
            asm volatile("s_waitcnt vmcnt(0)" ::: "memory");
        }
    }
    __syncthreads();
}
constexpr int LDS_BYTES = 147456, LDS_BARST = LDS_BYTES - 64;
#ifdef PH_ONLY
#define IN(k) ((k) == PH_ONLY && lo <= (k) && (k) < hi)
#else
#define IN(k) (lo <= (k) && (k) < hi)
#endif
#if MK_SPLIT
#define SEAM(k) do { } while (0)
#else
#define SEAM(k) do { if (IN(k) && IN((k) + 1)) { xcd_barrier(xbar); } } while (0)
#endif

template <class T> __device__ __forceinline__ T* gptr(GAS T* p) { return (T*)p; }
__device__ __forceinline__ unsigned char* opq(GAS unsigned char* p) { asm volatile("" : "+s"(p)); return (unsigned char*)p; }
#ifndef PROBE_MASK
#define PROBE_MASK 0
#endif
#if PROBE_MASK
#define PH_REP(k) _Pragma("unroll 1") for (int rep_ = 0; rep_ < (((PROBE_MASK >> (k)) & 1) ? 2 : 1); ++rep_)
#else
#define PH_REP(k)
#endif
#define PHASE_VARS const int lane = fresh_lane(), wave = __builtin_amdgcn_readfirstlane(threadIdx.x >> 6), tid = wave * 64 + lane, gw = bid * 8 + wave, NGW = G * 8, gt = bid * 512 + tid, NGT = G * 512; (void)gw; (void)NGW; (void)gt; (void)NGT; unsigned char* ws = opq(a.ws); float* ss = (float*)(ws + WS_SS); float* rope = (float*)(ws + WS_ROPE); bf16_t* h16 = (bf16_t*)(ws + WS_H16); float* hbuf = gptr(a.out); (void)ss; (void)rope; (void)h16; (void)hbuf

template <int GRP>
__device__ __forceinline__ void convert_group(const Args& a, unsigned char* ws, LAS unsigned char* lds, int gw, int NGW, int wave, int lane) {
    LAS float* scr = (LAS float*)(lds + wave * 16640);
    const float* mixn = gptr(a.in[2]); const float* xan = gptr(a.in[17]); const float* xamn = gptr(a.in[18]); const float* ffn = gptr(a.in[22]);
    constexpr int I_WIN = 16 * 56, I_G = 4 * 4 * 4, I_WOUT = 24 * 16, I_CQKV = 16 * 20, I_COUT = 16 * 16, I_XQ = 16 * 8, I_XKV = 16 * 16, I_XO = 8 * 16, I_GU = 16 * 88, I_DN = 44 * 16;
    constexpr int NITEMS = GRP == 0 ? (I_WIN + 2 * I_G + I_WOUT + I_XQ + 2 * I_XKV + I_XO) : (GRP == 1 ? (I_CQKV + I_GU + I_DN) : (I_COUT + I_XQ + I_XO + I_GU + I_DN));
    constexpr int l = GRP == 2 ? 1 : 0;
    for (int it = gw; it < NITEMS; it += NGW) {
        int r = it;
        if (GRP == 0) {
            if (r < I_WIN) { tr_plain(gptr(a.in[3]), 1024, 3584, mixn, (bf16_t*)(ws + WS_WIN), r, scr, lane); continue; } r -= I_WIN;
            if (r < 2 * I_G) { const int gsel = r / I_G; r %= I_G; const int hh = r / 16, rr = r % 16, kb = rr / 4, nb = rr % 4;
                const float* W = (gsel == 0 ? gptr(a.in[6]) : gptr(a.in[8])) + (size_t)hh * 65536; const int n0 = 64 * nb;
                tr_tile(W, 256, nullptr, (bf16_t*)(ws + WS_GT), 256, 64 * kb, n0, hh * 512 + (n0 >> 7) * 256 + gsel * 128 + (n0 & 127), scr, lane); continue; } r -= 2 * I_G;
            if (r < I_WOUT) { tr_plain(gptr(a.in[11]), 1536, 1024, nullptr, (bf16_t*)(ws + WS_WOUT), r, scr, lane); continue; } r -= I_WOUT;
            if (r < 2 * I_XKV) { const int lk = r / I_XKV; r %= I_XKV; tr_plain(gptr(a.in[20]) + (size_t)lk * 1024 * 1024, 1024, 1024, xamn + lk * 1024, (bf16_t*)(ws + WS_XAKV) + (size_t)lk * 1024 * 1024, r, scr, lane); continue; } r -= 2 * I_XKV;
        }
        if (GRP == 1) {
            if (r < I_CQKV) { tr_plain(gptr(a.in[12]), 1024, 1280, mixn + 1024, (bf16_t*)(ws + WS_CQKV), r, scr, lane); continue; } r -= I_CQKV;
        }
        if (GRP == 2) {
            if (r < I_COUT) { tr_plain(gptr(a.in[15]), 1024, 1024, nullptr, (bf16_t*)(ws + WS_COUT), r, scr, lane); continue; } r -= I_COUT;
        }
        if (GRP == 0 || GRP == 2) {
            if (r < I_XQ) { tr_plain(gptr(a.in[19]) + (size_t)l * 1024 * 512, 1024, 512, xan + l * 1024, (bf16_t*)(ws + WS_XAQ) + (size_t)l * 512 * 1024, r, scr, lane); continue; } r -= I_XQ;
            if (r < I_XO) { tr_plain(gptr(a.in[21]) + (size_t)l * 512 * 1024, 512, 1024, nullptr, (bf16_t*)(ws + WS_XAO) + (size_t)l * 1024 * 512, r, scr, lane); continue; } r -= I_XO;
        }
        if (GRP == 1 || GRP == 2) {
            if (r < I_GU) { const int kb = r / 88, nb = r % 88, n0 = 64 * nb; const int j0 = n0 < DFF ? n0 : n0 - DFF;
                tr_tile(gptr(a.in[23]) + (size_t)l * 1024 * 5632, 5632, ffn + l * 1024, (bf16_t*)(ws + WS_GU) + (size_t)l * 5632 * 1024, 1024, 64 * kb, n0, (j0 >> 7) * 256 + (n0 < DFF ? 0 : 128) + (j0 & 127), scr, lane); continue; } r -= I_GU;
            tr_plain(gptr(a.in[24]) + (size_t)l * DFF * 1024, DFF, 1024, nullptr, (bf16_t*)(ws + WS_DN) + (size_t)l * 1024 * DFF, r, scr, lane);
        }
    }
}

template <int layer, int px>
__device__ __forceinline__ void xa_ffn(const Args& a, LAS unsigned char* lds, const int lo, const int hi, const XcdBarrier& xbar) {
    const int G = gridDim.x, bid = blockIdx.x;

    constexpr int SS_XA = (layer == 0 ? 1 : 4) * M, SS_FFN = (layer == 0 ? 2 : 5) * M, SS_NEXT = (layer == 0 ? 3 : 6) * M;
    PH_REP(px) if (IN(px)) { PHASE_VARS;
        pg8::Gemm g{h16, (const bf16_t*)(ws + WS_XAQ) + (size_t)layer * 512 * 1024, M, 512, 1024, 1024, 1024, 0, 0}; pg8::StaticOrder S; S.init(M, 512, G, bid, !(layer == 0 && G == 256));
        EpiScale E{ss + SS_XA, (bf16_t*)(ws + A_XQ), 512};
        pg8::gemm_phase<(layer == 1)>(lds, g, S, E);
        if (layer == 0 && G == 256) {
            if (bid >= 160) convert_group<1>(a, ws, lds, (bid - 160) * 8 + wave, 96 * 8, wave, lane);
            else if (bid >= 128) { const int l = (bid - 128) >> 4;
                pg8::Gemm g2{(const bf16_t*)(ws + WS_MEM16), (const bf16_t*)(ws + WS_XAKV) + (size_t)l * 1024 * 1024, 1024, 1024, 1024, 1024, 1024, 0, 0};
                pg8::StaticOrder S2; S2.init(1024, 1024, G, (bid - 128) & 15, false);
                EpiScale E2{ss + 7 * M, (bf16_t*)(ws + WS_MEMKV) + (size_t)l * 1024 * 1024, 1024};
                pg8::gemm_phase(lds, g2, S2, E2); }
        }
    }
    SEAM(px);
    PH_REP(px + 1) if (IN(px + 1)) { PHASE_VARS;
        const bf16_t* xq = (const bf16_t*)(ws + A_XQ); const bf16_t* mkv = (const bf16_t*)(ws + WS_MEMKV) + (size_t)layer * 1024 * 1024; bf16_t* xo = (bf16_t*)(ws + A_XO);
        { DecXA dec{xq, mkv, xo}; attn_phase<128, 1, 1>(lds, dec, 512, 0.08838834764831845f); }
    }
    SEAM(px + 1);
    PH_REP(px + 2) if (IN(px + 2)) { PHASE_VARS;
        pg8::Gemm g{(const bf16_t*)(ws + A_XO), (const bf16_t*)(ws + WS_XAO) + (size_t)layer * 1024 * 512, M, 1024, 512, 512, 512, 0, 0}; pg8::StaticOrder S; S.init(M, 1024, G, bid);
        EpiResid<false, false> E{nullptr, h16, nullptr, h16, nullptr, ss + SS_FFN};
        pg8::gemm_phase(lds, g, S, E);
    }
    SEAM(px + 2);
    PH_REP(px + 3) if (IN(px + 3)) { PHASE_VARS;
        pg8::Gemm g{h16, (const bf16_t*)(ws + WS_GU) + (size_t)layer * 5632 * 1024, M, 5632, 1024, 1024, 1024, 0, 0}; pg8::StaticOrder S; S.init(M, 5632, G, bid, true);
        EpiSwiglu E{ss + SS_FFN, (bf16_t*)(ws + A_FF)};
        pg8::gemm_phase<true>(lds, g, S, E);
    }
    SEAM(px + 3);
    PH_REP(px + 4) if (IN(px + 4)) { PHASE_VARS;
        pg8::Gemm g{(const bf16_t*)(ws + A_FF), (const bf16_t*)(ws + WS_DN) + (size_t)layer * 1024 * DFF, M, 1024, DFF, DFF, DFF, 0, 0}; pg8::StaticOrder S; S.init(M, 1024, G, bid);
        if (layer == 1 && G == 256) { EpiFinal E{h16, hbuf, gptr(a.in[25]), ss + SS_NEXT, (unsigned*)(ws + WS_PCNT)}; pg8::gemm_phase(lds, g, S, E); }
        else if (layer == 1) { EpiResid<false, true> E{nullptr, h16, hbuf, nullptr, nullptr, ss + SS_NEXT}; pg8::gemm_phase(lds, g, S, E); }
        else { EpiResid<false, false> E{nullptr, h16, nullptr, h16, nullptr, ss + SS_NEXT}; pg8::gemm_phase(lds, g, S, E); }
    }
    if (!(layer == 1 && G == 256)) SEAM(px + 4);

}

__global__ void __launch_bounds__(512, 2) fwd_mega(Args a) {
    extern __shared__ __attribute__((aligned(16))) unsigned char lds_raw[];
    LAS unsigned char* lds = (LAS unsigned char*)lds_raw;
    const int G = gridDim.x, bid = blockIdx.x;
    const int lo = a.ph_lo, hi = a.ph_hi;
    if (threadIdx.x < 16) ((volatile LAS unsigned*)(lds + LDS_BARST))[threadIdx.x] = 0u;
    __syncthreads();
#if !MK_SPLIT
    if (a.ph_hi > NPHASE) cg::this_grid().sync();
#endif
    XcdBarrier xbar; xbar.bar = (unsigned*)(unsigned char*)a.ws; xbar.x = 0; xbar.st = nullptr;
#if !MK_SPLIT
    xbar = xcd_barrier_post((unsigned*)(unsigned char*)a.ws, (volatile LAS unsigned*)(lds + LDS_BARST));
#endif

    PH_REP(0) if (IN(0)) { PHASE_VARS;
        convert_group<0>(a, ws, lds, gw, NGW, wave, lane);
        if (G != 256) { convert_group<1>(a, ws, lds, gw, NGW, wave, lane); convert_group<2>(a, ws, lds, gw, NGW, wave, lane); }
        for (int m = gw; m < M; m += NGW) row_to_bf16_ss(gptr(a.in[0]) + (size_t)m * DM, h16 + (size_t)m * DM, ss + m, lane);
        for (int m = gw; m < NB * NMEM; m += NGW) row_to_bf16_ss(gptr(a.in[1]) + (size_t)m * DM, (bf16_t*)(ws + WS_MEM16) + (size_t)m * DM, ss + 7 * M + m, lane);
        for (int i = gt; i < 6 * M; i += NGT) ss[M + i] = 0.f;
        for (int i = gt; i < SEQ * 8; i += NGT) { const int t = i >> 3, j = i & 7; const float inv = powf(500000.0f, -(float)j * 0.125f); const float ang = (float)t * inv;
            const double rev = (double)ang * 0.15915494309189535; const float fr = (float)(rev - rint(rev));
            rope[t * 16 + j] = __builtin_amdgcn_cosf(fr); rope[t * 16 + 8 + j] = __builtin_amdgcn_sinf(fr); }
    }
    SEAM(0);

    {
    PH_REP(1) if (IN(1)) { PHASE_VARS;
        { pg8::Gemm g{h16, (const bf16_t*)(ws + WS_WIN), M, 3584, 1024, 1024, 1024, 0, 0}; pg8::StaticOrder S; S.init(M, 3584, G, bid, true);
          EpiProj0 E{ss, rope, (bf16_t*)(ws + A_XBR), (bf16_t*)(ws + A_YG), (bf16_t*)(ws + A_Q), (bf16_t*)(ws + A_K), (bf16_t*)(ws + A_V)};
          pg8::gemm_phase<true>(lds, g, S, E); }
        if (G != 256)
#pragma unroll
        for (int l = 0; l < 2; ++l) { pg8::Gemm g{(const bf16_t*)(ws + WS_MEM16), (const bf16_t*)(ws + WS_XAKV) + (size_t)l * 1024 * 1024, 1024, 1024, 1024, 1024, 1024, 0, 0};
          pg8::StaticOrder S; S.init(1024, 1024, G, (bid + G - (G / 2 + 16 * l) % G) % G);
          EpiScale E{ss + 7 * M, (bf16_t*)(ws + WS_MEMKV) + (size_t)l * 1024 * 1024, 1024};
          pg8::gemm_phase(lds, g, S, E); }
    }
    SEAM(1);
    PH_REP(2) if (IN(2)) { PHASE_VARS;
        const bf16_t* xbr = (const bf16_t*)(ws + A_XBR); bf16_t* xc = h16; const float* cw = gptr(a.in[4]); const float* cb = gptr(a.in[5]);
        for (int i = gt; i < (M / 8) * 128; i += NGT) { const int row0 = (i >> 7) * 8, c8 = (i & 127) * 8;
            f32x4 w0[4], w1[4];
#pragma unroll
            for (int tap = 0; tap < 4; ++tap) { w0[tap] = *(const f32x4*)(cw + tap * 1024 + c8); w1[tap] = *(const f32x4*)(cw + tap * 1024 + c8 + 4); }
            const f32x4 bb0 = *(const f32x4*)(cb + c8), bb1 = *(const f32x4*)(cb + c8 + 4);
            f32x4 xa0, xa1, xb0, xb1, xc0, xc1;
            if ((row0 & (SEQ - 1)) == 0) { xa0 = xa1 = xb0 = xb1 = xc0 = xc1 = (f32x4){0.f, 0.f, 0.f, 0.f}; }
            else { unpack8(*(const u32x4*)(xbr + (size_t)(row0 - 3) * 1024 + c8), xa0, xa1); unpack8(*(const u32x4*)(xbr + (size_t)(row0 - 2) * 1024 + c8), xb0, xb1); unpack8(*(const u32x4*)(xbr + (size_t)(row0 - 1) * 1024 + c8), xc0, xc1); }
            u32x4 xin[8];
#pragma unroll
            for (int r = 0; r < 8; ++r) xin[r] = *(const u32x4*)(xbr + (size_t)(row0 + r) * 1024 + c8);
#pragma unroll
            for (int r = 0; r < 8; ++r) { f32x4 xd0, xd1; unpack8(xin[r], xd0, xd1);
                const f32x4 y0 = bb0 + xa0 * w0[0] + xb0 * w0[1] + xc0 * w0[2] + xd0 * w0[3], y1 = bb1 + xa1 * w1[0] + xb1 * w1[1] + xc1 * w1[2] + xd1 * w1[3];
                *(u32x4*)(xc + (size_t)(row0 + r) * 1024 + c8) = pack8(y0, y1);
                xa0 = xb0; xa1 = xb1; xb0 = xc0; xb1 = xc1; xc0 = xd0; xc1 = xd1; } }
        const bf16_t* q = (const bf16_t*)(ws + A_Q); const bf16_t* k = (const bf16_t*)(ws + A_K); const bf16_t* v = (const bf16_t*)(ws + A_V);
        bf16_t* ob = (bf16_t*)gptr(a.out); float* lse = (float*)((unsigned char*)gptr(a.out) + OUT_LSE);
        { DecL0 dec{q, k, v, ob, lse}; attn_phase<64, 0, 2>(lds, dec, 1536, 0.125f); }
    }
    SEAM(2);
    PH_REP(3) if (IN(3)) { PHASE_VARS;
        pg8::Gemm g{h16, (const bf16_t*)(ws + WS_GT), M, 2048, 256, 1024, 256, 1, 256}; pg8::StaticOrder S; S.init(M, 2048, G, bid);
        EpiGates E{h16, gptr(a.in[7]), gptr(a.in[9]), gptr(a.in[10]), (bf16_t*)(ws + A_XBR), (bf16_t*)(ws + A_U)};
        pg8::gemm_phase(lds, g, S, E);
    }
    SEAM(3);
    PH_REP(4) if (IN(4)) { PHASE_VARS;
        const unsigned* la = (const unsigned*)(ws + A_XBR); const unsigned* uu = (const unsigned*)(ws + A_U);
        float* CA = (float*)(ws + WS_CA); float* CH = (float*)(ws + WS_CH);
        for (int i = gt; i < NB * 64 * 512; i += NGT) { const int cp = i & 511, seg = (i >> 9) & 63, b = i >> 15; const size_t base = ((size_t)b * SEQ + seg * 64) * 512 + cp;
            float A0 = 1.f, A1 = 1.f, H0 = 0.f, H1 = 0.f;
#pragma unroll 32
            for (int t = 0; t < 64; ++t) { const unsigned lw = la[base + (size_t)t * 512], uw = uu[base + (size_t)t * 512];
                const float a0 = __expf(bf_lo(lw)), a1 = __expf(bf_hi(lw)); A0 *= a0; A1 *= a1; H0 = a0 * H0 + bf_lo(uw); H1 = a1 * H1 + bf_hi(uw); }
            const size_t co = ((size_t)b * 64 + seg) * 1024 + cp * 2; CA[co] = A0; CA[co + 1] = A1; CH[co] = H0; CH[co + 1] = H1; }
    }
    SEAM(4);
    PH_REP(5) if (IN(5)) { PHASE_VARS;
        const unsigned* la = (const unsigned*)(ws + A_XBR); const unsigned* uu = (const unsigned*)(ws + A_U); const unsigned* yg = (const unsigned*)(ws + A_YG);
        const float* CA = (const float*)(ws + WS_CA); const float* CH = (const float*)(ws + WS_CH); bf16_t* cat = (bf16_t*)(ws + A_CAT);
        for (int i = gt; i < NB * 64 * 512; i += NGT) { const int cp = i & 511, seg = (i >> 9) & 63, b = i >> 15; const size_t base = ((size_t)b * SEQ + seg * 64) * 512 + cp;
            float H0 = 0.f, H1 = 0.f;
#pragma unroll 16
            for (int s = 0; s < seg; ++s) { const size_t co = ((size_t)b * 64 + s) * 1024 + cp * 2; const f32x2 av = *(const f32x2*)(CA + co), hv = *(const f32x2*)(CH + co); H0 = av.x * H0 + hv.x; H1 = av.y * H1 + hv.y; }
#pragma unroll 16
            for (int t = 0; t < 64; ++t) { const unsigned lw = la[base + (size_t)t * 512], uw = uu[base + (size_t)t * 512], yw = yg[base + (size_t)t * 512];
                H0 = __expf(bf_lo(lw)) * H0 + bf_lo(uw); H1 = __expf(bf_hi(lw)) * H1 + bf_hi(uw);
                *(unsigned*)(cat + ((size_t)b * SEQ + seg * 64 + t) * 1536 + cp * 2) = cvt_pk_bf16(H0 * bf_lo(yw), H1 * bf_hi(yw)); }
        }
        const bf16_t* ob = (const bf16_t*)gptr(a.out); const float* lse = (const float*)((const unsigned char*)gptr(a.out) + OUT_LSE);
        for (int i = gt; i < M * 64; i += NGT) { const int row = i >> 6, c8 = (i & 63) * 8, h = c8 >> 6;
            const float l0 = lse[(size_t)row * 8 + h], l1 = lse[(size_t)M * 8 + (size_t)row * 8 + h], l2 = lse[(size_t)2 * M * 8 + (size_t)row * 8 + h];
            const float mxl = fmaxf(l0, fmaxf(l1, l2)); float w0 = __expf(l0 - mxl), w1 = __expf(l1 - mxl), w2 = __expf(l2 - mxl); const float iw = 1.0f / (w0 + w1 + w2); w0 *= iw; w1 *= iw; w2 *= iw;
            f32x4 a0, a1, b0, b1, c0, c1; unpack8(*(const u32x4*)(ob + (size_t)row * 512 + c8), a0, a1); unpack8(*(const u32x4*)(ob + (size_t)M * 512 + (size_t)row * 512 + c8), b0, b1);
            unpack8(*(const u32x4*)(ob + (size_t)2 * M * 512 + (size_t)row * 512 + c8), c0, c1);
            *(u32x4*)(cat + (size_t)row * 1536 + 1024 + c8) = pack8(a0 * w0 + b0 * w1 + c0 * w2, a1 * w0 + b1 * w1 + c1 * w2); }
    }
    SEAM(5);
    PH_REP(6) if (IN(6)) { PHASE_VARS;
        pg8::Gemm g{(const bf16_t*)(ws + A_CAT), (const bf16_t*)(ws + WS_WOUT), M, 1024, 1536, 1536, 1536, 0, 0}; pg8::StaticOrder S; S.init(M, 1024, G, bid);
        EpiResid<true, false> E{gptr(a.in[0]), nullptr, nullptr, h16, nullptr, ss + 1 * M};
        pg8::gemm_phase(lds, g, S, E);
    }
    SEAM(6);
    }
    xa_ffn<0, 7>(a, lds, lo, hi, xbar);
    {
    PH_REP(12) if (IN(12)) { PHASE_VARS;
        pg8::Gemm g{h16, (const bf16_t*)(ws + WS_CQKV), M, 1280, 1024, 1024, 1024, 0, 0}; pg8::StaticOrder S; S.init(M, 1280, G, bid, true);
        EpiQkv1 E{ss + 3 * M, rope, gptr(a.in[13]), (bf16_t*)(ws + A_Q1), (bf16_t*)(ws + A_KV1)};
        pg8::gemm_phase<true>(lds, g, S, E);
        if (G == 256 && bid >= 128) convert_group<2>(a, ws, lds, (bid - 128) * 8 + wave, 128 * 8, wave, lane);
    }
    SEAM(12);
    PH_REP(13) if (IN(13)) { PHASE_VARS;
        const bf16_t* q = (const bf16_t*)(ws + A_Q1); const bf16_t* kv = (const bf16_t*)(ws + A_KV1); bf16_t* o = (bf16_t*)(ws + A_O1); const float* sinks = gptr(a.in[14]);
        { DecL1 dec{q, kv, o, sinks}; attn_phase<64, 0, 2>(lds, dec, 1024, 0.125f); }
    }
    SEAM(13);
    PH_REP(14) if (IN(14)) { PHASE_VARS;
        pg8::Gemm g{(const bf16_t*)(ws + A_O1), (const bf16_t*)(ws + WS_COUT), M, 1024, 1024, 1024, 1024, 0, 0}; pg8::StaticOrder S; S.init(M, 1024, G, bid);
        EpiResid<false, false> E{nullptr, h16, nullptr, h16, gptr(a.in[16]), ss + 4 * M};
        pg8::gemm_phase(lds, g, S, E);
    }
    SEAM(14);
    }
    xa_ffn<1, 15>(a, lds, lo, hi, xbar);
    PH_REP(20) if (IN(20) && G != 256) { PHASE_VARS;
        const float* fg = gptr(a.in[25]);
        for (int m = gw; m < M; m += NGW) { const float rinv = rsqrtf(ss[6 * M + m] * (1.0f / DM) + EPS); f32x4* xr = (f32x4*)(hbuf + (size_t)m * DM) + lane; const f32x4* gr = (const f32x4*)fg + lane;
#pragma unroll
            for (int j = 0; j < 4; ++j) xr[64 * j] = xr[64 * j] * rinv * gr[64 * j]; }
    }
#undef IN
#undef SEAM
}

extern "C" void kernel_launch(void* const* d_in, const int* in_sizes, int n_in, void* d_out, int out_size, void* d_ws, size_t ws_size, hipStream_t stream) {
    static int grid = 0;
    if (grid == 0) {
        int dev = 0, cus = 0, per_cu = 0;
        if (n_in != 26 || out_size != M * DM || ws_size < 256 * MiB) { fprintf(stderr, "kernel_launch: unexpected shapes (n_in %d out %d ws %zu)\n", n_in, out_size, ws_size); grid = -1; return; }
        hipGetDevice(&dev); hipDeviceGetAttribute(&cus, hipDeviceAttributeMultiprocessorCount, dev);
        if (hipFuncSetAttribute((const void*)fwd_mega, hipFuncAttributeMaxDynamicSharedMemorySize, LDS_BYTES) != hipSuccess) { fprintf(stderr, "kernel_launch: hipFuncSetAttribute failed\n"); grid = -1; return; }
        if (hipOccupancyMaxActiveBlocksPerMultiprocessor(&per_cu, (const void*)fwd_mega, 512, LDS_BYTES) != hipSuccess || per_cu < 1) { fprintf(stderr, "kernel_launch: occupancy query says %d\n", per_cu); per_cu = 1; }
        (void)hipGetLastError();
        grid = cus * 1;
        if (grid <= 0) grid = 256;
    }
    if (grid < 0) return;
    Args a{};
    for (int i = 0; i < 26; ++i) a.in[i] = (const GAS float*)d_in[i];
    a.out = (GAS float*)d_out; a.ws = (GAS unsigned char*)d_ws;
    if (hipMemsetAsync(d_ws, 0, 65536, stream) != hipSuccess) { fprintf(stderr, "kernel_launch: memset failed\n"); return; }
#if MK_SPLIT
    for (int p = 0; p < NPHASE; ++p) { a.ph_lo = p; a.ph_hi = p + 1;
        for (int rep = 0; rep < 1 + ((HOST_REP_MASK >> p) & 1); ++rep) hipLaunchKernelGGL(fwd_mega, dim3(grid), dim3(512), LDS_BYTES, stream, a); }
#else
    a.ph_lo = 0; a.ph_hi = NPHASE;
    void* args[] = {&a};
    hipError_t e = hipLaunchCooperativeKernel((const void*)fwd_mega, dim3(grid), dim3(512), args, LDS_BYTES, stream);
    if (e != hipSuccess) fprintf(stderr, "cooperative launch failed: %s (grid %d)\n", hipGetErrorString(e), grid);
#endif
}
```

```cpp
#include <hip/hip_runtime.h>
#include <hip/hip_cooperative_groups.h>
#include <cstdio>
#include <cstdint>
namespace cg = cooperative_groups;

#ifndef HOST_REP_MASK
#define HOST_REP_MASK 0
#endif
#ifndef MK_SPLIT
#define MK_SPLIT 0
#endif

#define LAS __attribute__((address_space(3)))
typedef unsigned short bf16_t;
typedef short bf16x8 __attribute__((ext_vector_type(8)));
typedef float f32x4 __attribute__((ext_vector_type(4)));
typedef float f32x2 __attribute__((ext_vector_type(2)));
typedef unsigned u32x4 __attribute__((ext_vector_type(4)));
typedef unsigned u32x2 __attribute__((ext_vector_type(2)));

constexpr int M = 16384, SEQ = 4096, NB = 4, DM = 1024, DFF = 2816, NMEM = 256;
constexpr float EPS = 1e-6f;
constexpr size_t MiB = 1u << 20;
constexpr size_t WS_PCNT = 16384;
constexpr size_t WS_SS = 1 * MiB;
constexpr size_t WS_ROPE = 2 * MiB;
constexpr size_t WS_CA = 3 * MiB, WS_CH = 4 * MiB;
constexpr size_t WS_MEM16 = 5 * MiB;
constexpr size_t WS_MEMKV = 7 * MiB;
constexpr size_t WS_WIN = 12 * MiB;
constexpr size_t WS_GT = 19 * MiB;
constexpr size_t WS_WOUT = 20 * MiB;
constexpr size_t WS_CQKV = 23 * MiB;
constexpr size_t WS_COUT = WS_CQKV + 2560 * 1024;
constexpr size_t WS_XAQ = WS_COUT + 2 * MiB;
constexpr size_t WS_XAKV = WS_XAQ + 2 * MiB;
constexpr size_t WS_XAO = WS_XAKV + 4 * MiB;
constexpr size_t WS_GU = WS_XAO + 2 * MiB;
constexpr size_t WS_DN = WS_GU + 22 * MiB;
constexpr size_t WS_H16 = 70 * MiB;
constexpr size_t WS_ACT = 104 * MiB;
static_assert(WS_DN + 11 * MiB <= WS_H16, "weights fit");
constexpr size_t A_XBR = WS_ACT, A_YG = WS_ACT + 32 * MiB, A_Q = WS_ACT + 64 * MiB, A_K = A_Q + 16 * MiB, A_V = A_K + 16 * MiB, A_CAT = A_Q, A_U = WS_ACT + 112 * MiB;
constexpr size_t A_XQ = WS_ACT, A_XO = WS_ACT + 16 * MiB, A_FF = WS_ACT, A_Q1 = WS_ACT, A_KV1 = WS_ACT + 32 * MiB, A_O1 = WS_ACT + 40 * MiB;
static_assert(A_U + 32 * MiB <= 256 * MiB, "ws fits");
static_assert(A_K - A_Q == 16 * MiB && A_V - A_K == 16 * MiB, "q|k|v spacing used by EpiProj0");
constexpr size_t OUT_LSE = 48 * MiB;

namespace pg8 {
constexpr int BM = 256, BK = 64, HALF = 128, HTB = HALF * BK * 2, STAGE_BYTES = 8 * HTB, NXCD = 8, WGM = 8;
__host__ __device__ __forceinline__ int lds_byte(int r, int c) { const int st = (r >> 4) * 2 + (c >> 5), rr = r & 15, cc = c & 31, ob = rr * 64 + cc * 2; return st * 1024 + (ob ^ (((ob >> 9) & 1) << 5)); }
__host__ __device__ __forceinline__ void stage_rc(int b, int& R, int& C) { const int st = b / 1024, sb = b % 1024, swz = sb ^ (((sb >> 9) & 1) << 5); R = (st >> 1) * 16 + swz / 64; C = (st & 1) * 32 + (swz % 64) / 2; }
__host__ __device__ __forceinline__ int perm32(int rho) { const int n = rho >> 4, i = rho & 15; return 8 * (i >> 2) + 4 * n + (i & 3); }

struct Unit { int pm, pn, nh, h0; };
struct Gemm { const bf16_t* A; const bf16_t* Bt; int M, N, K, lda, ldb, a_shift, a_goff; };

struct StaticOrder {
    int nM, nN, nwg, G, c, nfull, rem; bool th;
    __host__ __device__ __forceinline__ void init(int M_, int N_, int G_, int c_, bool halves = false) { nM = M_ / BM; nN = N_ / BM; nwg = nM * nN; G = G_; c = c_; rem = nwg % G; nfull = nwg - rem; th = halves && rem > 0 && 2 * rem <= G; }
    __host__ __device__ __forceinline__ bool next(int i, Unit& u) const {
        const long L = (long)i * G + c; int wgid; u.nh = 2; u.h0 = 0;
        if (th && L >= nfull) { const long e = L - nfull; if (e >= 2 * rem) return false; wgid = nfull + (int)(e >> 1); u.h0 = (int)(e & 1); u.nh = 1; }
        else { if (L >= nwg) return false; wgid = (int)L; }
        { const int q = nwg / NXCD, r = nwg % NXCD, xcd = wgid % NXCD, off = wgid / NXCD; wgid = (xcd < r ? xcd * (q + 1) : r * (q + 1) + (xcd - r) * q) + off; }
        const int nig = WGM * nN, gid = wgid / nig, fm = gid * WGM, gsz = (nM - fm) < WGM ? (nM - fm) : WGM;
        u.pm = fm + ((wgid % nig) % gsz); u.pn = (wgid % nig) / gsz; return true;
    }
};

template <bool HALVES = false, class Epi>
__device__ __forceinline__ void gemm_phase(LAS unsigned char* lds, const Gemm g, const StaticOrder& S, const Epi& E) {
    const int tid = threadIdx.x, wid = __builtin_amdgcn_readfirstlane(tid >> 6), lane = tid & 63, wr = wid >> 2, wc = wid & 3, fr = lane & 15, fq = lane >> 4;
    const int K = g.K, nt = K / BK;
    unsigned voffA[2], voffB[2];
#pragma unroll
    for (int i = 0; i < 2; ++i) { int R, C; stage_rc(tid * 16 + i * 8192, R, C); const int Rb = (R & ~31) + perm32(R & 31);
        voffA[i] = (unsigned)(R * g.lda + C) * 2u; voffB[i] = (unsigned)(Rb * g.ldb + C) * 2u; }
    constexpr unsigned kstep = BK * 2;
    const unsigned hstepA = (unsigned)HALF * g.lda * 2u, hstepB = (unsigned)HALF * g.ldb * 2u;
    const unsigned tstepA = 2 * hstepA, tstepB = 2 * hstepB;
    const unsigned ldsw = (unsigned)wid * 1024u;
    const int aoff = lds_byte(wr * 64 + fr, fq * 8), boff = lds_byte(wc * 32 + fr, fq * 8);
#define PG8_SA(b, h) (((b) * 2 + (h)) * HTB)
#define PG8_SB(b, h) ((4 + (b) * 2 + (h)) * HTB)
#define PG8_STAGE(bufoff, gbase, voff) do { _Pragma("unroll") for (int _i = 0; _i < 2; ++_i) \
        __builtin_amdgcn_global_load_lds((const unsigned*)((const char*)(gbase) + (voff)[_i]), (LAS unsigned*)(lds + (bufoff) + ldsw + _i * 8192), 16, 0, 0); } while (0)
#define PG8_LDA(dst, b, h) do { _Pragma("unroll") for (int m = 0; m < 4; ++m) _Pragma("unroll") for (int k = 0; k < 2; ++k) dst[m][k] = *(const LAS bf16x8*)(lds + PG8_SA(b, h) + aoff + m * 2048 + k * 1024); } while (0)
#define PG8_LDB(dst, b, h) do { _Pragma("unroll") for (int n = 0; n < 2; ++n) _Pragma("unroll") for (int k = 0; k < 2; ++k) dst[n][k] = *(const LAS bf16x8*)(lds + PG8_SB(b, h) + boff + n * 2048 + k * 1024); } while (0)
#define PG8_MMA(ai, bj, At, Bt) do { __builtin_amdgcn_s_setprio(1); _Pragma("unroll") for (int m = 0; m < 4; ++m) _Pragma("unroll") for (int n = 0; n < 2; ++n) _Pragma("unroll") for (int k = 0; k < 2; ++k) \
        acc[ai][bj][m][n] = __builtin_amdgcn_mfma_f32_16x16x32_bf16(Bt[n][k], At[m][k], acc[ai][bj][m][n], 0, 0, 0); __builtin_amdgcn_s_setprio(0); } while (0)
#define PG8_WAIT_V(n) asm volatile("s_waitcnt vmcnt(" #n ")" ::: "memory")
#define PG8_WAIT_L(n) asm volatile("s_waitcnt lgkmcnt(" #n ")" ::: "memory")
#define PG8_BAR __builtin_amdgcn_s_barrier()
#define PG8_SCHED __builtin_amdgcn_sched_barrier(0)
#define PG8_UA(u) ((const char*)g.A + (size_t)(u).pm * tstepA + (size_t)(u).h0 * hstepA + (size_t)(((u).pn >> g.a_shift) * g.a_goff) * 2)
#define PG8_HA(u) ((!HALVES || (u).nh == 2) ? hstepA : 0u)
#define PG8_UB(u) ((const char*)g.Bt + (size_t)(u).pn * tstepB)
    Unit cur, nxt; int ui = 0;
    if (!S.next(0, cur)) return;
    f32x4 acc[2][2][4][2];
#pragma unroll
    for (int a = 0; a < 2; ++a)
#pragma unroll
        for (int b = 0; b < 2; ++b)
#pragma unroll
            for (int m = 0; m < 4; ++m)
#pragma unroll
                for (int n = 0; n < 2; ++n) acc[a][b][m][n] = (f32x4){0.f, 0.f, 0.f, 0.f};
    bf16x8 At[4][2], B0[2][2], B1[2][2];
    const char* cA = PG8_UA(cur); const char* cB = PG8_UB(cur); unsigned cHA = PG8_HA(cur);
    PG8_STAGE(PG8_SB(0, 0), cB, voffB); PG8_STAGE(PG8_SB(0, 1), cB + hstepB, voffB); PG8_STAGE(PG8_SA(0, 0), cA, voffA); PG8_STAGE(PG8_SA(0, 1), cA + cHA, voffA);
    if (wr == 1) PG8_BAR;
    PG8_WAIT_V(2); PG8_BAR;
    PG8_STAGE(PG8_SB(1, 0), cB + kstep, voffB); PG8_STAGE(PG8_SA(1, 0), cA + kstep, voffA); PG8_STAGE(PG8_SB(1, 1), cB + hstepB + kstep, voffB);
    PG8_WAIT_V(6); PG8_BAR;
    for (;;) {
        const bool has_next = S.next(ui + 1, nxt);
        const char* nA = has_next ? PG8_UA(nxt) : cA; const char* nB = has_next ? PG8_UB(nxt) : cB; const unsigned nHA = has_next ? PG8_HA(nxt) : cHA; const bool full = !HALVES || cur.nh == 2;
#define PG8_KLOOP(FULLC) _Pragma("unroll 1") for (int t = 0; t < nt; t += 2) { \
            const bool last = (t == nt - 2); \
            const char* a1 = cA + (size_t)(t + 1) * kstep; \
            const char* a2 = last ? nA : cA + (size_t)(t + 2) * kstep; const char* b2 = last ? nB : cB + (size_t)(t + 2) * kstep; \
            const char* a3 = a2 + kstep; const char* b3 = b2 + kstep; const unsigned h2 = last ? nHA : cHA; \
            PG8_LDB(B0, 0, 0); PG8_LDB(B1, 0, 1); PG8_SCHED; PG8_LDA(At, 0, 0); PG8_STAGE(PG8_SA(1, 1), a1 + cHA, voffA); \
            PG8_WAIT_V(8); PG8_WAIT_L(0); PG8_BAR; PG8_MMA(0, 0, At, B0); PG8_MMA(0, 1, At, B1); PG8_BAR; PG8_SCHED; \
            if (FULLC) PG8_LDA(At, 0, 1); PG8_STAGE(PG8_SB(0, 0), b2, voffB); PG8_STAGE(PG8_SB(0, 1), b2 + hstepB, voffB); PG8_STAGE(PG8_SA(0, 0), a2, voffA); \
            PG8_WAIT_V(8); PG8_WAIT_L(0); PG8_BAR; if (FULLC) { PG8_MMA(1, 0, At, B0); PG8_MMA(1, 1, At, B1); } PG8_BAR; PG8_SCHED; \
            PG8_LDB(B0, 1, 0); PG8_LDB(B1, 1, 1); PG8_SCHED; PG8_LDA(At, 1, 0); PG8_STAGE(PG8_SA(0, 1), a2 + h2, voffA); \
            PG8_WAIT_V(8); PG8_WAIT_L(0); PG8_BAR; PG8_MMA(0, 0, At, B0); PG8_MMA(0, 1, At, B1); PG8_BAR; PG8_SCHED; \
            if (FULLC) PG8_LDA(At, 1, 1); PG8_STAGE(PG8_SB(1, 0), b3, voffB); PG8_STAGE(PG8_SB(1, 1), b3 + hstepB, voffB); PG8_STAGE(PG8_SA(1, 0), a3, voffA); \
            PG8_WAIT_V(8); PG8_WAIT_L(0); PG8_BAR; if (FULLC) { PG8_MMA(1, 0, At, B0); PG8_MMA(1, 1, At, B1); } PG8_BAR; PG8_SCHED; \
        }
        if (full) { PG8_KLOOP(true) } else { PG8_KLOOP(false) }
#undef PG8_KLOOP
        if (wr == 0) PG8_BAR;
        E(acc, cur, wr, wc, fr, fq);
        if (!has_next) break;
#pragma unroll
        for (int a = 0; a < 2; ++a)
#pragma unroll
            for (int b = 0; b < 2; ++b)
#pragma unroll
                for (int m = 0; m < 4; ++m)
#pragma unroll
                    for (int n = 0; n < 2; ++n) acc[a][b][m][n] = (f32x4){0.f, 0.f, 0.f, 0.f};
        cur = nxt; cA = nA; cB = nB; cHA = nHA; ++ui;
        if (wr == 1) PG8_BAR;
    }
    PG8_WAIT_V(0);
    PG8_BAR;
#undef PG8_SA
#undef PG8_SB
#undef PG8_STAGE
#undef PG8_LDA
#undef PG8_LDB
#undef PG8_MMA
#undef PG8_WAIT_V
#undef PG8_WAIT_L
#undef PG8_BAR
#undef PG8_SCHED
#undef PG8_UA
#undef PG8_HA
#undef PG8_UB
}
}

__device__ __forceinline__ unsigned cvt_pk_bf16(float lo, float hi) { unsigned r; asm volatile("v_cvt_pk_bf16_f32 %0, %1, %2" : "=v"(r) : "v"(lo), "v"(hi)); return r; }
__device__ __forceinline__ u32x4 pack8(f32x4 a, f32x4 b) { u32x4 w; w.x = cvt_pk_bf16(a[0], a[1]); w.y = cvt_pk_bf16(a[2], a[3]); w.z = cvt_pk_bf16(b[0], b[1]); w.w = cvt_pk_bf16(b[2], b[3]); return w; }
__device__ __forceinline__ float bf_lo(unsigned w) { return __uint_as_float(w << 16); }
__device__ __forceinline__ float bf_hi(unsigned w) { return __uint_as_float(w & 0xffff0000u); }
__device__ __forceinline__ void unpack8(u32x4 w, f32x4& a, f32x4& b) { a = (f32x4){bf_lo(w.x), bf_hi(w.x), bf_lo(w.y), bf_hi(w.y)}; b = (f32x4){bf_lo(w.z), bf_hi(w.z), bf_lo(w.w), bf_hi(w.w)}; }
__device__ __forceinline__ float frcp(float x) { return __builtin_amdgcn_rcpf(x); }
__device__ __forceinline__ float fexp(float x) { return __builtin_amdgcn_exp2f(x * 1.4426950408889634f); }
__device__ __forceinline__ float sigmoidf_(float x) { return frcp(1.0f + fexp(-x)); }
__device__ __forceinline__ float gelu_tanh(float x) { const float z = 0.7978845608028654f * (x + 0.044715f * x * x * x); return x * frcp(1.0f + fexp(-2.0f * z)); }
__device__ __forceinline__ float silu_(float x) { return x * frcp(1.0f + fexp(-x)); }
__device__ __forceinline__ float wave_sum(float v) {
#pragma unroll
    for (int o = 1; o < 64; o <<= 1) v += __shfl_xor(v, o);
    return v;
}

typedef f32x4 Acc[2][2][4][2];
__device__ __forceinline__ int fresh_lane() { int l; asm volatile("v_mbcnt_lo_u32_b32 %0, -1, 0\n\tv_mbcnt_hi_u32_b32 %0, -1, %0" : "=v"(l)); return l; }
#define EPI_LANES() const int l_ = fresh_lane(); const int fr = l_ & 15, fq = l_ >> 4; (void)fr_; (void)fq_
struct RopeRow { f32x4 c0, c1, s0, s1; };
__device__ __forceinline__ RopeRow rope_load(const float* rope, int t) { RopeRow r; r.c0 = *(const f32x4*)(rope + t * 16); r.c1 = *(const f32x4*)(rope + t * 16 + 4); r.s0 = *(const f32x4*)(rope + t * 16 + 8); r.s1 = *(const f32x4*)(rope + t * 16 + 12); return r; }
__device__ __forceinline__ void rope8(f32x4& v0, f32x4& v1, const RopeRow& rr, int fq) {
    f32x4 p0, p1;
#pragma unroll
    for (int e = 0; e < 4; ++e) { p0[e] = __shfl_xor(v0[e], 16); p1[e] = __shfl_xor(v1[e], 16); }
    if (fq == 0) { v0 = v0 * rr.c0 - p0 * rr.s0; v1 = v1 * rr.c1 - p1 * rr.s1; }
    else if (fq == 1) { v0 = v0 * rr.c0 + p0 * rr.s0; v1 = v1 * rr.c1 + p1 * rr.s1; }
}

struct EpiProj0 {
    const float* ss; const float* rope; bf16_t *xbr, *yg, *q, *k, *v;
    __device__ __forceinline__ void operator()(const Acc& acc, const pg8::Unit& u, int wr, int wc, int fr_, int fq_) const {
        EPI_LANES();
        const int row0 = u.pm * 256 + u.h0 * 128 + wr * 64 + fr, colw = wc * 32 + 8 * fq, pn = u.pn;
        bf16_t* dst; int ld, cb;
        if (pn < 4) { dst = xbr; ld = 1024; cb = pn * 256; }
        else if (pn < 8) { dst = yg; ld = 1024; cb = (pn - 4) * 256; }
        else { const int t3 = (pn - 8) >> 1; dst = q + (size_t)t3 * 8388608;     ld = 512; cb = ((pn - 8) & 1) * 256; }
        const bool do_gelu = (pn >= 4 && pn < 8), do_rope = (pn >= 8 && pn < 12 && (wc & 1) == 0);
        float ssv[2][4];
#pragma unroll
        for (int ai = 0; ai < 2; ++ai)
#pragma unroll
            for (int m = 0; m < 4; ++m) ssv[ai][m] = ss[row0 + ai * 128 + m * 16];
#pragma unroll
        for (int ai = 0; ai < 2; ++ai) if (ai < u.nh)
#pragma unroll
            for (int m = 0; m < 4; ++m) { const int row = row0 + ai * 128 + m * 16; const float rinv = rsqrtf(ssv[ai][m] * (1.0f / DM) + EPS);
                RopeRow rr; if (do_rope) rr = rope_load(rope, row & (SEQ - 1));
#pragma unroll
                for (int bj = 0; bj < 2; ++bj) { f32x4 v0 = acc[ai][bj][m][0] * rinv, v1 = acc[ai][bj][m][1] * rinv;
                    if (do_gelu) {
#pragma unroll
                        for (int e = 0; e < 4; ++e) { v0[e] = gelu_tanh(v0[e]); v1[e] = gelu_tanh(v1[e]); } }
                    if (do_rope) rope8(v0, v1, rr, fq);
                    *(u32x4*)(dst + (size_t)row * ld + cb + bj * 128 + colw) = pack8(v0, v1); } }
    }
};
struct EpiGates {
    const bf16_t* xc; const float *ba, *bx, *lam; bf16_t *la, *uo;
    __device__ __forceinline__ void operator()(const Acc& acc, const pg8::Unit& u, int wr, int wc, int fr_, int fq_) const {
        EPI_LANES();
        const int row0 = u.pm * 256 + u.h0 * 128 + wr * 64 + fr, ch = (u.pn >> 1) * 256 + (u.pn & 1) * 128 + wc * 32 + 8 * fq;
        f32x4 nsp[2], bav[2], bxv[2];
#pragma unroll
        for (int n = 0; n < 2; ++n) { const f32x4 lm = *(const f32x4*)(lam + ch + 4 * n); bav[n] = *(const f32x4*)(ba + ch + 4 * n); bxv[n] = *(const f32x4*)(bx + ch + 4 * n);
#pragma unroll
            for (int e = 0; e < 4; ++e) { const float x = fexp(-lm[e]); nsp[n][e] = -8.0f * (x * (1.0f - x * (0.5f - x * (0.3333333333f - 0.25f * x)))); } }
        u32x4 xws[2][4];
#pragma unroll
        for (int ai = 0; ai < 2; ++ai)
#pragma unroll
            for (int m = 0; m < 4; ++m) xws[ai][m] = *(const u32x4*)(xc + (size_t)(row0 + ai * 128 + m * 16) * 1024 + ch);
#pragma unroll
        for (int ai = 0; ai < 2; ++ai) if (ai < u.nh)
#pragma unroll
            for (int m = 0; m < 4; ++m) { const size_t off = (size_t)(row0 + ai * 128 + m * 16) * 1024 + ch;
                f32x4 x[2], lg[2], uu[2]; unpack8(xws[ai][m], x[0], x[1]);
#pragma unroll
                for (int n = 0; n < 2; ++n)
#pragma unroll
                    for (int e = 0; e < 4; ++e) { const float r = sigmoidf_(acc[ai][0][m][n][e] + bav[n][e]), ig = sigmoidf_(acc[ai][1][m][n][e] + bxv[n][e]); lg[n][e] = nsp[n][e] * r;
                        uu[n][e] = __builtin_amdgcn_sqrtf(fmaxf(1.0f - fexp(2.0f * lg[n][e]), 0.f)) * ig * x[n][e]; }
                *(u32x4*)(la + off) = pack8(lg[0], lg[1]); *(u32x4*)(uo + off) = pack8(uu[0], uu[1]); }
    }
};
template <bool BASE_F32, bool OUT_F32>
struct EpiResid {
    const float* basef; const bf16_t* baseh; float* outf; bf16_t* h16; const float* bias; float* ssn;
    __device__ __forceinline__ void operator()(const Acc& acc, const pg8::Unit& u, int wr, int wc, int fr_, int fq_) const {
        EPI_LANES();
        const int row0 = u.pm * 256 + u.h0 * 128 + wr * 64 + fr, col0 = u.pn * 256 + wc * 32 + 8 * fq;
        f32x4 bv[2][2];
#pragma unroll
        for (int bj = 0; bj < 2; ++bj)
#pragma unroll
            for (int n = 0; n < 2; ++n) bv[bj][n] = bias ? *(const f32x4*)(bias + col0 + bj * 128 + 4 * n) : (f32x4){0.f, 0.f, 0.f, 0.f};
        u32x4 bb[4][2];
        if (!BASE_F32) {
#pragma unroll
            for (int m = 0; m < 4; ++m)
#pragma unroll
                for (int bj = 0; bj < 2; ++bj) bb[m][bj] = *(const u32x4*)(baseh + (size_t)(row0 + m * 16) * DM + col0 + bj * 128);
        }
#pragma unroll
        for (int ai = 0; ai < 2; ++ai) if (ai < u.nh)
#pragma unroll
            for (int m = 0; m < 4; ++m) { const int row = row0 + ai * 128 + m * 16; float sq = 0.f;
#pragma unroll
                for (int bj = 0; bj < 2; ++bj) { const size_t off = (size_t)row * DM + col0 + bj * 128;
                    f32x4 b0, b1;
                    if (BASE_F32) { b0 = *(const f32x4*)(basef + off); b1 = *(const f32x4*)(basef + off + 4); } else { unpack8(bb[m][bj], b0, b1); if (ai == 0 && u.nh == 2) bb[m][bj] = *(const u32x4*)(baseh + off + (size_t)128 * DM); }
                    const f32x4 v0 = acc[ai][bj][m][0] + bv[bj][0] + b0, v1 = acc[ai][bj][m][1] + bv[bj][1] + b1;
                    if (OUT_F32) { *(f32x4*)(outf + off) = v0; *(f32x4*)(outf + off + 4) = v1; } else *(u32x4*)(h16 + off) = pack8(v0, v1);
                    sq += (v0[0] * v0[0] + v0[1] * v0[1]) + (v0[2] * v0[2] + v0[3] * v0[3]) + (v1[0] * v1[0] + v1[1] * v1[1]) + (v1[2] * v1[2] + v1[3] * v1[3]); }
                sq += __shfl_xor(sq, 16); sq += __shfl_xor(sq, 32);
                if (fq == 0) atomicAdd(ssn + row, sq); if (BASE_F32) asm volatile("" ::: "memory"); }
    }
};
struct EpiFinal {
    const bf16_t* baseh; float* out; const float* gain; float* ssn; unsigned* cnt;
    __device__ __forceinline__ void operator()(Acc& acc, const pg8::Unit& u, int wr, int wc, int fr_, int fq_) const {
        EPI_LANES();
        const int row0 = u.pm * 256 + u.h0 * 128 + wr * 64 + fr, col0 = u.pn * 256 + wc * 32 + 8 * fq;
        u32x4 bb[4][2];
#pragma unroll
        for (int m = 0; m < 4; ++m)
#pragma unroll
            for (int bj = 0; bj < 2; ++bj) bb[m][bj] = *(const u32x4*)(baseh + (size_t)(row0 + m * 16) * DM + col0 + bj * 128);
#pragma unroll
        for (int ai = 0; ai < 2; ++ai) if (ai < u.nh)
#pragma unroll
            for (int m = 0; m < 4; ++m) { const int row = row0 + ai * 128 + m * 16; float sq = 0.f;
#pragma unroll
                for (int bj = 0; bj < 2; ++bj) { f32x4 b0, b1; unpack8(bb[m][bj], b0, b1); if (ai == 0) bb[m][bj] = *(const u32x4*)(baseh + (size_t)(row0 + 128 + m * 16) * DM + col0 + bj * 128);
                    const f32x4 v0 = acc[ai][bj][m][0] + b0, v1 = acc[ai][bj][m][1] + b1; acc[ai][bj][m][0] = v0; acc[ai][bj][m][1] = v1;
                    sq += (v0[0] * v0[0] + v0[1] * v0[1]) + (v0[2] * v0[2] + v0[3] * v0[3]) + (v1[0] * v1[0] + v1[1] * v1[1]) + (v1[2] * v1[2] + v1[3] * v1[3]); }
                sq += __shfl_xor(sq, 16); sq += __shfl_xor(sq, 32);
                if (fq == 0) atomicAdd(ssn + row, sq); }
        asm volatile("s_waitcnt vmcnt(0)" ::: "memory");
        __syncthreads();
        if (threadIdx.x == 0) { unsigned* c = cnt + 64 * u.pm;
            __hip_atomic_fetch_add(c, 1u, __ATOMIC_RELEASE, __HIP_MEMORY_SCOPE_AGENT);
            unsigned sp = 0; while (__hip_atomic_load(c, __ATOMIC_ACQUIRE, __HIP_MEMORY_SCOPE_AGENT) < 4u) { __builtin_amdgcn_s_sleep(1); if (++sp > (1u << 20)) break; } }
        __syncthreads();
        f32x4 gv[2][2];
#pragma unroll
        for (int bj = 0; bj < 2; ++bj)
#pragma unroll
            for (int n = 0; n < 2; ++n) gv[bj][n] = *(const f32x4*)(gain + col0 + bj * 128 + 4 * n);
#pragma unroll
        for (int ai = 0; ai < 2; ++ai) if (ai < u.nh)
#pragma unroll
            for (int m = 0; m < 4; ++m) { const int row = row0 + ai * 128 + m * 16;
                const float rinv = rsqrtf(__hip_atomic_load(ssn + row, __ATOMIC_RELAXED, __HIP_MEMORY_SCOPE_AGENT) * (1.0f / DM) + EPS);
#pragma unroll
                for (int bj = 0; bj < 2; ++bj) { const size_t off = (size_t)row * DM + col0 + bj * 128;
                    *(f32x4*)(out + off) = acc[ai][bj][m][0] * rinv * gv[bj][0]; *(f32x4*)(out + off + 4) = acc[ai][bj][m][1] * rinv * gv[bj][1]; } }
    }
};
struct EpiScale {
    const float* ss; bf16_t* out; int ldc;
    __device__ __forceinline__ void operator()(const Acc& acc, const pg8::Unit& u, int wr, int wc, int fr_, int fq_) const {
        EPI_LANES();
        const int row0 = u.pm * 256 + u.h0 * 128 + wr * 64 + fr, col0 = u.pn * 256 + wc * 32 + 8 * fq;
        float ssv[2][4];
#pragma unroll
        for (int ai = 0; ai < 2; ++ai)
#pragma unroll
            for (int m = 0; m < 4; ++m) ssv[ai][m] = ss[row0 + ai * 128 + m * 16];
#pragma unroll
        for (int ai = 0; ai < 2; ++ai) if (ai < u.nh)
#pragma unroll
            for (int m = 0; m < 4; ++m) { const int row = row0 + ai * 128 + m * 16; const float rinv = rsqrtf(ssv[ai][m] * (1.0f / DM) + EPS);
#pragma unroll
                for (int bj = 0; bj < 2; ++bj) *(u32x4*)(out + (size_t)row * ldc + col0 + bj * 128) = pack8(acc[ai][bj][m][0] * rinv, acc[ai][bj][m][1] * rinv); }
    }
};
struct EpiSwiglu {
    const float* ss; bf16_t* out;
    __device__ __forceinline__ void operator()(const Acc& acc, const pg8::Unit& u, int wr, int wc, int fr_, int fq_) const {
        EPI_LANES();
        const int row0 = u.pm * 256 + u.h0 * 128 + wr * 64 + fr, col0 = u.pn * 128 + wc * 32 + 8 * fq;
        float ssv[2][4];
#pragma unroll
        for (int ai = 0; ai < 2; ++ai)
#pragma unroll
            for (int m = 0; m < 4; ++m) ssv[ai][m] = ss[row0 + ai * 128 + m * 16];
#pragma unroll
        for (int ai = 0; ai < 2; ++ai) if (ai < u.nh)
#pragma unroll
            for (int m = 0; m < 4; ++m) { const int row = row0 + ai * 128 + m * 16; const float rinv = rsqrtf(ssv[ai][m] * (1.0f / DM) + EPS);
                f32x4 o0, o1;
#pragma unroll
                for (int e = 0; e < 4; ++e) { o0[e] = silu_(acc[ai][0][m][0][e] * rinv) * (acc[ai][1][m][0][e] * rinv); o1[e] = silu_(acc[ai][0][m][1][e] * rinv) * (acc[ai][1][m][1][e] * rinv); }
                *(u32x4*)(out + (size_t)row * DFF + col0) = pack8(o0, o1); }
    }
};
struct EpiQkv1 {
    const float* ss; const float* rope; const float* bias; bf16_t *q, *kv;
    __device__ __forceinline__ void operator()(const Acc& acc, const pg8::Unit& u, int wr, int wc, int fr_, int fq_) const {
        EPI_LANES();
        const int row0 = u.pm * 256 + u.h0 * 128 + wr * 64 + fr, colw = wc * 32 + 8 * fq, pn = u.pn;
        bf16_t* dst = pn < 4 ? q : kv; const int ld = pn < 4 ? 1024 : 256, cb = pn < 4 ? pn * 256 : 0;
        f32x4 bv[2][2];
#pragma unroll
        for (int bj = 0; bj < 2; ++bj)
#pragma unroll
            for (int n = 0; n < 2; ++n) bv[bj][n] = *(const f32x4*)(bias + pn * 256 + bj * 128 + colw + 4 * n);
        float ssv[2][4];
#pragma unroll
        for (int ai = 0; ai < 2; ++ai)
#pragma unroll
            for (int m = 0; m < 4; ++m) ssv[ai][m] = ss[row0 + ai * 128 + m * 16];
#pragma unroll
        for (int ai = 0; ai < 2; ++ai) if (ai < u.nh)
#pragma unroll
            for (int m = 0; m < 4; ++m) { const int row = row0 + ai * 128 + m * 16; const float rinv = rsqrtf(ssv[ai][m] * (1.0f / DM) + EPS);
                RopeRow rr; if ((wc & 1) == 0) rr = rope_load(rope, row & (SEQ - 1));
#pragma unroll
                for (int bj = 0; bj < 2; ++bj) { f32x4 v0 = acc[ai][bj][m][0] * rinv + bv[bj][0], v1 = acc[ai][bj][m][1] * rinv + bv[bj][1];
                    if ((wc & 1) == 0 && (pn < 4 || bj == 0)) rope8(v0, v1, rr, fq);
                    *(u32x4*)(dst + (size_t)row * ld + cb + bj * 128 + colw) = pack8(v0, v1); } }
    }
};

struct AU { const bf16_t *Qp, *Kp, *Vp; bf16_t* Op; float* lsep; long qstride, kstride, vstride, ostride, lsestride; int hasprev, maxd, has_sink; float sink; int kvkey; };
typedef short v4i16_t __attribute__((ext_vector_type(4)));
template <int HD, int MODE, int RT, class Dec>
__device__ __forceinline__ void attn_phase(LAS unsigned char* lds, const Dec& dec, int nunits, float scale) {
    constexpr int QW = 16 * RT, NK = MODE == 0 ? 128 + 128 * RT : 256;
    constexpr int PPR = HD / 8, KP = HD + 8, VPI = (HD == 64 ? 72 : 144), NIT = NK * PPR / 512;
    constexpr int NCH = MODE == 0 ? 5 : 8, NT = 2 * NCH, NC = HD / 32, NDT = HD / 16;
    static_assert((MODE == 1 && RT == 1) || (MODE == 0 && RT == 2), "dense mode: one row tile per wave; banded mode: two (the compile-time tile classes assume the 32-aligned window)");
    const int lane = fresh_lane(), w = __builtin_amdgcn_readfirstlane(threadIdx.x >> 6), tid = w * 64 + lane, l15 = lane & 15, quad = lane >> 4;
    LAS bf16_t* Kl = (LAS bf16_t*)lds; LAS bf16_t* Vl = Kl + NK * KP;
    const int G = gridDim.x;
    int u = (G % 8 == 0) ? (int)(blockIdx.x % 8) * (G / 8) + (int)(blockIdx.x / 8) : (int)blockIdx.x;
    if (u >= nunits) return;
    const int qq0 = QW * w + l15;
    AU cur; dec(u, cur);
    u32x4 kv[NIT], vv[NIT]; bf16x8 qf[RT][NC];
#define AT_LOADKV(au) do { _Pragma("unroll") for (int it = 0; it < NIT; ++it) { const int p = it * 512 + tid, key = p / PPR, part = p % PPR; const int ks = (MODE == 0 && !(au).hasprev && key < 128) ? key + 128 : key; \
        kv[it] = *(const u32x4*)((au).Kp + (long)ks * (au).kstride + part * 8); vv[it] = *(const u32x4*)((au).Vp + (long)ks * (au).vstride + part * 8); } } while (0)
#define AT_LOADQ(au, dst) do { _Pragma("unroll") for (int rt = 0; rt < RT; ++rt) _Pragma("unroll") for (int c = 0; c < NC; ++c) dst[rt][c] = *(const bf16x8*)((au).Qp + (long)(qq0 + 16 * rt) * (au).qstride + 32 * c + quad * 8); } while (0)
    constexpr bool PF = (HD == 64);
    if (PF) AT_LOADKV(cur);
    AT_LOADQ(cur, qf);
    bool need_stage = true;
    for (;;) {
        if (need_stage) {
            if (!PF) AT_LOADKV(cur);
#pragma unroll
            for (int it = 0; it < NIT; ++it) { const int p = it * 512 + tid, key = p / PPR, part = p % PPR;
                *(LAS u32x4*)(Kl + key * KP + part * 8) = kv[it]; *(LAS u32x4*)(Vl + key * VPI + part * 8) = vv[it]; }
        }
        __syncthreads();
        const int un = u + G; const bool has_next = un < nunits; AU nxt = cur; bool next_stage = false; bf16x8 qn[RT][NC];
#pragma unroll
        for (int rt = 0; rt < RT; ++rt)
#pragma unroll
            for (int c = 0; c < NC; ++c) qn[rt][c] = qf[rt][c];
        if (has_next) { dec(un, nxt); next_stage = nxt.kvkey != cur.kvkey; if (PF && next_stage) AT_LOADKV(nxt); AT_LOADQ(nxt, qn); }
        const int ch0 = MODE == 0 ? (RT == 2 ? w : (w >> 1)) : 0;
        const float cexp = scale * 1.4426950408889634f;
        f32x4 s[RT][NT];
        float mx[RT];
#pragma unroll
        for (int rt = 0; rt < RT; ++rt) mx[rt] = -3.0e38f;
#pragma unroll
        for (int t = 0; t < NT; ++t) {
            const int kmin = ch0 * 32 + 16 * t; const int kr = kmin + l15;
            const bool dead = MODE == 0 && !cur.hasprev && kmin < 128;
            if (!dead) {
                bf16x8 kf[NC];
#pragma unroll
                for (int c = 0; c < NC; ++c) kf[c] = *(const LAS bf16x8*)(Kl + kr * KP + 32 * c + quad * 8);
#pragma unroll
                for (int rt = 0; rt < RT; ++rt) { const int d = t - rt;
                    if (MODE == 0 && (d < 0 || d > 8)) { s[rt][t] = (f32x4){-1.0e30f, -1.0e30f, -1.0e30f, -1.0e30f}; }
                    else {
                        s[rt][t] = (f32x4){0.f, 0.f, 0.f, 0.f};
#pragma unroll
                        for (int c = 0; c < NC; ++c) s[rt][t] = __builtin_amdgcn_mfma_f32_16x16x32_bf16(kf[c], qf[rt][c], s[rt][t], 0, 0, 0);
                        if (MODE == 0 && (d == 0 || d == 8)) { const int qq = qq0 + 16 * rt;
#pragma unroll
                            for (int jj = 0; jj < 4; ++jj) { const int dist = 128 + qq - (kmin + quad * 4 + jj); s[rt][t][jj] = (dist >= 0 && dist <= cur.maxd) ? s[rt][t][jj] : -1.0e30f; } }
                        mx[rt] = fmaxf(fmaxf(mx[rt], fmaxf(s[rt][t][0], s[rt][t][1])), fmaxf(s[rt][t][2], s[rt][t][3]));
                    }
                }
            } else {
#pragma unroll
                for (int rt = 0; rt < RT; ++rt) s[rt][t] = (f32x4){-1.0e30f, -1.0e30f, -1.0e30f, -1.0e30f};
            }
        }
        float mnat[RT], lsum[RT];
#pragma unroll
        for (int rt = 0; rt < RT; ++rt) {
            float m_ = mx[rt]; m_ = fmaxf(m_, __shfl_xor(m_, 16)); m_ = fmaxf(m_, __shfl_xor(m_, 32));
            float mn = m_ * scale;
            if (cur.has_sink) mn = fmaxf(mn, cur.sink);
            const float moff = -mn * 1.4426950408889634f;
            float ls = 0.f;
#pragma unroll
            for (int t = 0; t < NT; ++t)
#pragma unroll
                for (int jj = 0; jj < 4; ++jj) { const float p = __builtin_amdgcn_exp2f(__builtin_fmaf(s[rt][t][jj], cexp, moff)); s[rt][t][jj] = p; ls += p; }
            ls += __shfl_xor(ls, 16); ls += __shfl_xor(ls, 32);
            if (cur.has_sink) ls += __expf(cur.sink - mn);
            mnat[rt] = mn; lsum[rt] = ls;
        }
        f32x4 o[RT][NDT];
#pragma unroll
        for (int rt = 0; rt < RT; ++rt)
#pragma unroll
            for (int dt = 0; dt < NDT; ++dt) o[rt][dt] = (f32x4){0.f, 0.f, 0.f, 0.f};
#pragma unroll
        for (int c = 0; c < NCH; ++c) { bf16x8 pf[RT];
#pragma unroll
            for (int rt = 0; rt < RT; ++rt) { const u32x4 pw = pack8(s[rt][2 * c], s[rt][2 * c + 1]); pf[rt] = __builtin_bit_cast(bf16x8, pw); }
            const LAS bf16_t* vb = Vl + ((ch0 + c) * 32 + quad * 4 + (l15 >> 2)) * VPI + 4 * (l15 & 3);
#pragma unroll
            for (int dt = 0; dt < NDT; ++dt) {
                const v4i16_t lo = __builtin_amdgcn_ds_read_tr16_b64_v4i16((LAS v4i16_t*)(vb + 16 * dt)), hi = __builtin_amdgcn_ds_read_tr16_b64_v4i16((LAS v4i16_t*)(vb + 16 * VPI + 16 * dt));
                const bf16x8 vf = (bf16x8){lo[0], lo[1], lo[2], lo[3], hi[0], hi[1], hi[2], hi[3]};
#pragma unroll
                for (int rt = 0; rt < RT; ++rt) o[rt][dt] = __builtin_amdgcn_mfma_f32_16x16x32_bf16(vf, pf[rt], o[rt][dt], 0, 0, 0); } }
#pragma unroll
        for (int rt = 0; rt < RT; ++rt) { const int qq = qq0 + 16 * rt;
            const float inv = frcp(lsum[rt]);
            bf16_t* orow = cur.Op + (long)qq * cur.ostride + quad * 4;
#pragma unroll
            for (int dt = 0; dt < NDT; ++dt) { u32x2 ow; ow.x = cvt_pk_bf16(o[rt][dt][0] * inv, o[rt][dt][1] * inv); ow.y = cvt_pk_bf16(o[rt][dt][2] * inv, o[rt][dt][3] * inv); *(u32x2*)(orow + 16 * dt) = ow; }
            if (cur.lsep && quad == 0) cur.lsep[(long)qq * cur.lsestride] = mnat[rt] + __logf(lsum[rt]); }
        __syncthreads();
        if (!has_next) break;
        cur = nxt; u = un; need_stage = next_stage;
#pragma unroll
        for (int rt = 0; rt < RT; ++rt)
#pragma unroll
            for (int c = 0; c < NC; ++c) qf[rt][c] = qn[rt][c];
    }
#undef AT_LOADKV
#undef AT_LOADQ
}
struct DecL0 {
    const bf16_t *q, *k, *v; bf16_t* ob; float* lse;
    __device__ __forceinline__ void operator()(int u, AU& a) const {
        const int i = u >> 8, uv = u & 255, x = uv >> 5, cl = uv & 31, br = i % 3, bh = x * 4 + (i / 3) * 2 + (cl >> 4), b = bh >> 3, h = bh & 7, blk2 = cl & 15;
        const int dd = br == 0 ? 1 : (br == 1 ? 4 : 16), nbk2 = 16 / dd, r = blk2 / nbk2, jp = blk2 % nbk2;
        const long rowq = (long)b * SEQ + (long)jp * 256 * dd + r, rowk = rowq - 128 * dd;
        a.Qp = q + rowq * 512 + h * 64; a.Kp = k + rowk * 512 + h * 64; a.Vp = v + rowk * 512 + h * 64; a.Op = ob + (size_t)br * M * 512 + rowq * 512 + h * 64; a.lsep = lse + (size_t)br * M * 8 + rowq * 8 + h;
        a.qstride = a.kstride = a.vstride = a.ostride = (long)dd * 512; a.lsestride = (long)dd * 8; a.hasprev = jp > 0; a.maxd = 128; a.has_sink = 0; a.sink = 0.f; a.kvkey = u;
    }
};
struct DecL1 {
    const bf16_t *q, *kv; bf16_t* o; const float* sinks;
    __device__ __forceinline__ void operator()(int u, AU& a) const {
        const int g = u >> 7, rest = u & 127, b = rest >> 5, kvh = (rest >> 4) & 1, jp = rest & 15, hq = kvh * 8 + g;
        const long rowq = (long)b * SEQ + jp * 256, rowk = rowq - 128;
        a.Qp = q + rowq * 1024 + hq * 64; a.Kp = kv + rowk * 256 + kvh * 64; a.Vp = kv + rowk * 256 + 128 + kvh * 64; a.Op = o + rowq * 1024 + hq * 64; a.lsep = nullptr;
        a.qstride = 1024; a.kstride = a.vstride = 256; a.ostride = 1024; a.lsestride = 0; a.hasprev = jp > 0; a.maxd = 127; a.has_sink = 1; a.sink = sinks[hq]; a.kvkey = rest;
    }
};
struct DecXA {
    const bf16_t *xq, *mkv; bf16_t* xo;
    __device__ __forceinline__ void operator()(int u, AU& a) const {
        const int i = u >> 8, rest = u & 255, b = rest >> 6, h = (rest >> 4) & 3, jb = (rest & 15) * 2 + i;
        const long rowq = (long)b * SEQ + jb * 128;
        a.Qp = xq + rowq * 512 + h * 128; a.Kp = mkv + (size_t)b * 256 * 1024 + h * 128; a.Vp = a.Kp + 512; a.Op = xo + rowq * 512 + h * 128; a.lsep = nullptr;
        a.qstride = 512; a.kstride = a.vstride = 1024; a.ostride = 512; a.lsestride = 0; a.hasprev = 1; a.maxd = 0; a.has_sink = 0; a.sink = 0.f; a.kvkey = rest >> 4;
    }
};

__device__ __forceinline__ void tr_tile(const float* W, int N, const float* gain, bf16_t* WT, int ldt, int k0, int n0, int drow0, LAS float* scr, int lane) {
    const int n4 = (lane & 15) * 4, kq = lane >> 4;
    f32x4 v[16];
#pragma unroll
    for (int i = 0; i < 16; ++i) v[i] = *(const f32x4*)(W + (size_t)(k0 + 4 * i + kq) * N + n0 + n4);
    if (gain) {
#pragma unroll
        for (int i = 0; i < 16; ++i) v[i] = v[i] * gain[k0 + 4 * i + kq]; }
#pragma unroll
    for (int i = 0; i < 16; ++i) { LAS float* d = scr + (4 * i + kq) * 65 + n4; d[0] = v[i].x; d[1] = v[i].y; d[2] = v[i].z; d[3] = v[i].w; }
    asm volatile("s_waitcnt lgkmcnt(0)" ::: "memory");
    const int c = lane & 7;
#pragma unroll
    for (int j = 0; j < 8; ++j) { const int n = (lane >> 3) + 8 * j; const LAS float* s = scr + (8 * c) * 65 + n;
        u32x4 o; o.x = cvt_pk_bf16(s[0 * 65], s[1 * 65]); o.y = cvt_pk_bf16(s[2 * 65], s[3 * 65]); o.z = cvt_pk_bf16(s[4 * 65], s[5 * 65]); o.w = cvt_pk_bf16(s[6 * 65], s[7 * 65]);
        *(u32x4*)(WT + (size_t)(drow0 + n) * ldt + k0 + 8 * c) = o; }
    asm volatile("s_waitcnt lgkmcnt(0)" ::: "memory");
}
__device__ __forceinline__ void tr_plain(const float* W, int K, int N, const float* gain, bf16_t* WT, int item, LAS float* scr, int lane) {
    const int nblk = N / 64, kb = item / nblk, nb = item % nblk; tr_tile(W, N, gain, WT, K, 64 * kb, 64 * nb, 64 * nb, scr, lane);
}
__device__ __forceinline__ void row_to_bf16_ss(const float* xrow, bf16_t* orow, float* ssp, int lane) {
    const f32x4* xr = (const f32x4*)xrow + lane; f32x4 v[4]; float s = 0.f;
#pragma unroll
    for (int j = 0; j < 4; ++j) { v[j] = xr[64 * j]; s += (v[j].x * v[j].x + v[j].y * v[j].y) + (v[j].z * v[j].z + v[j].w * v[j].w); }
    s = wave_sum(s);
    u32x2* o8 = (u32x2*)orow + lane;
#pragma unroll
    for (int j = 0; j < 4; ++j) { u32x2 ow; ow.x = cvt_pk_bf16(v[j].x, v[j].y); ow.y = cvt_pk_bf16(v[j].z, v[j].w); o8[64 * j] = ow; }
    if (lane == 0) *ssp = s;
}

#define GAS __attribute__((address_space(1)))
struct Args { const GAS float* in[26]; GAS float* out; GAS unsigned char* ws; int ph_lo, ph_hi; };
constexpr int NPHASE = 21;

#define XB_TMO      128
#define XB_XCNT(j)  (256  + 64 * (j))
#define XB_XSUB(j)  (1280 + 64 * (j))
#define XB_XGEN(j)  (2304 + 64 * (j))
#define XB_TOP      3328
#define XB_TOPGEN   3392
#define XCD_BAR_WORDS 3456
#define XB_SPIN_CAP (1u << 18)
__device__ __forceinline__ unsigned xb_ld(unsigned* p)              { return __hip_atomic_load(p, __ATOMIC_RELAXED, __HIP_MEMORY_SCOPE_AGENT); }
__device__ __forceinline__ unsigned xb_add(unsigned* p, unsigned v) { return __hip_atomic_fetch_add(p, v, __ATOMIC_RELAXED, __HIP_MEMORY_SCOPE_AGENT); }
__device__ __forceinline__ unsigned xb_xcc_id() { return (unsigned)__builtin_amdgcn_s_getreg((3 << 11) | 20) & 0xFu; }
#define XB_SPIN(cond, bar) do { unsigned _sp = 0; while (cond) { __builtin_amdgcn_s_sleep(1); \
    if ((++_sp & 255u) == 0u) { if (xb_ld(&(bar)[XB_TMO])) break; if (_sp > XB_SPIN_CAP) { atomicAdd(&(bar)[XB_TMO], 1u); break; } } } } while (0)
struct XcdBarrier { unsigned* bar; unsigned x; volatile LAS unsigned* st; };
__device__ __forceinline__ XcdBarrier xcd_barrier_post(unsigned* bar, volatile LAS unsigned* st) {
    XcdBarrier b; b.bar = bar; b.x = xb_xcc_id(); b.st = st;
    if (threadIdx.x == 0) (void)xb_add(&bar[XB_XCNT(b.x)], 1u);
    return b;
}
__device__ __forceinline__ void xcd_barrier_complete(unsigned* bar, unsigned x, unsigned& nloc, unsigned& nx) {
    const unsigned G = gridDim.x * gridDim.y * gridDim.z;
    unsigned sum, cnt, mine, sp = 0u;
    for (;;) {
        sum = 0u; cnt = 0u; mine = 0u;
#pragma unroll
        for (unsigned j = 0; j < 16; ++j) { const unsigned c = xb_ld(&bar[XB_XCNT(j)]); sum += c; cnt += (c > 0u) ? 1u : 0u; mine = (j == x) ? c : mine; }
        if (sum == G) break;
        __builtin_amdgcn_s_sleep(1);
        if ((++sp & 255u) == 0u) { if (xb_ld(&bar[XB_TMO])) break; if (sp > XB_SPIN_CAP) { atomicAdd(&bar[XB_TMO], 1u); break; } }
    }
    nloc = mine > 0u ? mine : 1u; nx = cnt > 0u ? cnt : 1u;
}
__device__ __forceinline__ void xcd_barrier(const XcdBarrier& b) {
    asm volatile("s_waitcnt vmcnt(0)" ::: "memory");
    __syncthreads();
    if (threadIdx.x == 0) {
        unsigned* bar = b.bar;
        __builtin_amdgcn_s_waitcnt(0);
        asm volatile("buffer_inv sc1" ::: "memory");
        unsigned nloc = b.st[0], nx = b.st[1];
        if (nloc == 0u) { xcd_barrier_complete(bar, b.x, nloc, nx); b.st[0] = nloc; b.st[1] = nx; }
        const unsigned old = xb_add(&bar[XB_XSUB(b.x)], 1u);
        const unsigned gen = old / nloc;
        if (old + 1u == (gen + 1u) * nloc) {
            __builtin_amdgcn_fence(__ATOMIC_RELEASE, "agent");
            asm volatile("s_waitcnt vmcnt(0)" ::: "memory");
            (void)__hip_atomic_fetch_add(&bar[XB_TOP], 1u, __ATOMIC_RELAXED, __HIP_MEMORY_SCOPE_AGENT);
        }
        XB_SPIN(xb_ld(&bar[XB_TOP]) < (gen + 1u) * nx, bar);
        asm volatile("s_waitcnt vmcnt(0)" ::: "memory");
    }
    __syncthreads();
}
constexpr int LDS_BYTES = 147456, LDS_BARST = LDS_BYTES - 64;
#ifdef PH_ONLY
#define IN(k) ((k) == PH_ONLY && lo <= (k) && (k) < hi)
#else
#define IN(k) (lo <= (k) && (k) < hi)
#endif
#if MK_SPLIT
#define SEAM(k) do { } while (0)
#else
#define SEAM(k) do { if (IN(k) && IN((k) + 1)) { xcd_barrier(xbar); } } while (0)
#endif

template <class T> __device__ __forceinline__ T* gptr(GAS T* p) { return (T*)p; }
__device__ __forceinline__ unsigned char* opq(GAS unsigned char* p) { asm volatile("" : "+s"(p)); return (unsigned char*)p; }
#ifndef PROBE_MASK
#define PROBE_MASK 0
#endif
#if PROBE_MASK
#define PH_REP(k) _Pragma("unroll 1") for (int rep_ = 0; rep_ < (((PROBE_MASK >> (k)) & 1) ? 2 : 1); ++rep_)
#else
#define PH_REP(k)
#endif
#define PHASE_VARS const int lane = fresh_lane(), wave = __builtin_amdgcn_readfirstlane(threadIdx.x >> 6), tid = wave * 64 + lane, gw = bid * 8 + wave, NGW = G * 8, gt = bid * 512 + tid, NGT = G * 512; (void)gw; (void)NGW; (void)gt; (void)NGT; unsigned char* ws = opq(a.ws); float* ss = (float*)(ws + WS_SS); float* rope = (float*)(ws + WS_ROPE); bf16_t* h16 = (bf16_t*)(ws + WS_H16); float* hbuf = gptr(a.out); (void)ss; (void)rope; (void)h16; (void)hbuf

template <int GRP>
__device__ __forceinline__ void convert_group(const Args& a, unsigned char* ws, LAS unsigned char* lds, int gw, int NGW, int wave, int lane) {
    LAS float* scr = (LAS float*)(lds + wave * 16640);
    const float* mixn = gptr(a.in[2]); const float* xan = gptr(a.in[17]); const float* xamn = gptr(a.in[18]); const float* ffn = gptr(a.in[22]);
    constexpr int I_WIN = 16 * 56, I_G = 4 * 4 * 4, I_WOUT = 24 * 16, I_CQKV = 16 * 20, I_COUT = 16 * 16, I_XQ = 16 * 8, I_XKV = 16 * 16, I_XO = 8 * 16, I_GU = 16 * 88, I_DN = 44 * 16;
    constexpr int NITEMS = GRP == 0 ? (I_WIN + 2 * I_G + I_WOUT + I_XQ + 2 * I_XKV + I_XO) : (GRP == 1 ? (I_CQKV + I_GU + I_DN) : (I_COUT + I_XQ + I_XO + I_GU + I_DN));
    constexpr int l = GRP == 2 ? 1 : 0;
    for (int it = gw; it < NITEMS; it += NGW) {
        int r = it;
        if (GRP == 0) {
            if (r < I_WIN) { tr_plain(gptr(a.in[3]), 1024, 3584, mixn, (bf16_t*)(ws + WS_WIN), r, scr, lane); continue; } r -= I_WIN;
            if (r < 2 * I_G) { const int gsel = r / I_G; r %= I_G; const int hh = r / 16, rr = r % 16, kb = rr / 4, nb = rr % 4;
                const float* W = (gsel == 0 ? gptr(a.in[6]) : gptr(a.in[8])) + (size_t)hh * 65536; const int n0 = 64 * nb;
                tr_tile(W, 256, nullptr, (bf16_t*)(ws + WS_GT), 256, 64 * kb, n0, hh * 512 + (n0 >> 7) * 256 + gsel * 128 + (n0 & 127), scr, lane); continue; } r -= 2 * I_G;
            if (r < I_WOUT) { tr_plain(gptr(a.in[11]), 1536, 1024, nullptr, (bf16_t*)(ws + WS_WOUT), r, scr, lane); continue; } r -= I_WOUT;
            if (r < 2 * I_XKV) { const int lk = r / I_XKV; r %= I_XKV; tr_plain(gptr(a.in[20]) + (size_t)lk * 1024 * 1024, 1024, 1024, xamn + lk * 1024, (bf16_t*)(ws + WS_XAKV) + (size_t)lk * 1024 * 1024, r, scr, lane); continue; } r -= 2 * I_XKV;
        }
        if (GRP == 1) {
            if (r < I_CQKV) { tr_plain(gptr(a.in[12]), 1024, 1280, mixn + 1024, (bf16_t*)(ws + WS_CQKV), r, scr, lane); continue; } r -= I_CQKV;
        }
        if (GRP == 2) {
            if (r < I_COUT) { tr_plain(gptr(a.in[15]), 1024, 1024, nullptr, (bf16_t*)(ws + WS_COUT), r, scr, lane); continue; } r -= I_COUT;
        }
        if (GRP == 0 || GRP == 2) {
            if (r < I_XQ) { tr_plain(gptr(a.in[19]) + (size_t)l * 1024 * 512, 1024, 512, xan + l * 1024, (bf16_t*)(ws + WS_XAQ) + (size_t)l * 512 * 1024, r, scr, lane); continue; } r -= I_XQ;
            if (r < I_XO) { tr_plain(gptr(a.in[21]) + (size_t)l * 512 * 1024, 512, 1024, nullptr, (bf16_t*)(ws + WS_XAO) + (size_t)l * 1024 * 512, r, scr, lane); continue; } r -= I_XO;
        }
        if (GRP == 1 || GRP == 2) {
            if (r < I_GU) { const int kb = r / 88, nb = r % 88, n0 = 64 * nb; const int j0 = n0 < DFF ? n0 : n0 - DFF;
                tr_tile(gptr(a.in[23]) + (size_t)l * 1024 * 5632, 5632, ffn + l * 1024, (bf16_t*)(ws + WS_GU) + (size_t)l * 5632 * 1024, 1024, 64 * kb, n0, (j0 >> 7) * 256 + (n0 < DFF ? 0 : 128) + (j0 & 127), scr, lane); continue; } r -= I_GU;
            tr_plain(gptr(a.in[24]) + (size_t)l * DFF * 1024, DFF, 1024, nullptr, (bf16_t*)(ws + WS_DN) + (size_t)l * 1024 * DFF, r, scr, lane);
        }
    }
}

template <int layer, int px>
__device__ __forceinline__ void xa_ffn(const Args& a, LAS unsigned char* lds, const int lo, const int hi, const XcdBarrier& xbar) {
    const int G = gridDim.x, bid = blockIdx.x;

    constexpr int SS_XA = (layer == 0 ? 1 : 4) * M, SS_FFN = (layer == 0 ? 2 : 5) * M, SS_NEXT = (layer == 0 ? 3 : 6) * M;
    PH_REP(px) if (IN(px)) { PHASE_VARS;
        pg8::Gemm g{h16, (const bf16_t*)(ws + WS_XAQ) + (size_t)layer * 512 * 1024, M, 512, 1024, 1024, 1024, 0, 0}; pg8::StaticOrder S; S.init(M, 512, G, bid, !(layer == 0 && G == 256));
        EpiScale E{ss + SS_XA, (bf16_t*)(ws + A_XQ), 512};
        pg8::gemm_phase<(layer == 1)>(lds, g, S, E);
        if (layer == 0 && G == 256) {
            if (bid >= 160) convert_group<1>(a, ws, lds, (bid - 160) * 8 + wave, 96 * 8, wave, lane);
            else if (bid >= 128) { const int l = (bid - 128) >> 4;
                pg8::Gemm g2{(const bf16_t*)(ws + WS_MEM16), (const bf16_t*)(ws + WS_XAKV) + (size_t)l * 1024 * 1024, 1024, 1024, 1024, 1024, 1024, 0, 0};
                pg8::StaticOrder S2; S2.init(1024, 1024, G, (bid - 128) & 15, false);
                EpiScale E2{ss + 7 * M, (bf16_t*)(ws + WS_MEMKV) + (size_t)l * 1024 * 1024, 1024};
                pg8::gemm_phase(lds, g2, S2, E2); }
        }
    }
    SEAM(px);
    PH_REP(px + 1) if (IN(px + 1)) { PHASE_VARS;
        const bf16_t* xq = (const bf16_t*)(ws + A_XQ); const bf16_t* mkv = (const bf16_t*)(ws + WS_MEMKV) + (size_t)layer * 1024 * 1024; bf16_t* xo = (bf16_t*)(ws + A_XO);
        { DecXA dec{xq, mkv, xo}; attn_phase<128, 1, 1>(lds, dec, 512, 0.08838834764831845f); }
    }
    SEAM(px + 1);
    PH_REP(px + 2) if (IN(px + 2)) { PHASE_VARS;
        pg8::Gemm g{(const bf16_t*)(ws + A_XO), (const bf16_t*)(ws + WS_XAO) + (size_t)layer * 1024 * 512, M, 1024, 512, 512, 512, 0, 0}; pg8::StaticOrder S; S.init(M, 1024, G, bid);
        EpiResid<false, false> E{nullptr, h16, nullptr, h16, nullptr, ss + SS_FFN};
        pg8::gemm_phase(lds, g, S, E);
    }
    SEAM(px + 2);
    PH_REP(px + 3) if (IN(px + 3)) { PHASE_VARS;
        pg8::Gemm g{h16, (const bf16_t*)(ws + WS_GU) + (size_t)layer * 5632 * 1024, M, 5632, 1024, 1024, 1024, 0, 0}; pg8::StaticOrder S; S.init(M, 5632, G, bid, true);
        EpiSwiglu E{ss + SS_FFN, (bf16_t*)(ws + A_FF)};
        pg8::gemm_phase<true>(lds, g, S, E);
    }
    SEAM(px + 3);
    PH_REP(px + 4) if (IN(px + 4)) { PHASE_VARS;
        pg8::Gemm g{(const bf16_t*)(ws + A_FF), (const bf16_t*)(ws + WS_DN) + (size_t)layer * 1024 * DFF, M, 1024, DFF, DFF, DFF, 0, 0}; pg8::StaticOrder S; S.init(M, 1024, G, bid);
        if (layer == 1 && G == 256) { EpiFinal E{h16, hbuf, gptr(a.in[25]), ss + SS_NEXT, (unsigned*)(ws + WS_PCNT)}; pg8::gemm_phase(lds, g, S, E); }
        else if (layer == 1) { EpiResid<false, true> E{nullptr, h16, hbuf, nullptr, nullptr, ss + SS_NEXT}; pg8::gemm_phase(lds, g, S, E); }
        else { EpiResid<false, false> E{nullptr, h16, nullptr, h16, nullptr, ss + SS_NEXT}; pg8::gemm_phase(lds, g, S, E); }
    }
    if (!(layer == 1 && G == 256)) SEAM(px + 4);

}

__global__ void __launch_bounds__(512, 2) fwd_mega(Args a) {
    extern __shared__ __attribute__((aligned(16))) unsigned char lds_raw[];
    LAS unsigned char* lds = (LAS unsigned char*)lds_raw;
    const int G = gridDim.x, bid = blockIdx.x;
    const int lo = a.ph_lo, hi = a.ph_hi;
    if (threadIdx.x < 16) ((volatile LAS unsigned*)(lds + LDS_BARST))[threadIdx.x] = 0u;
    __syncthreads();
#if !MK_SPLIT
    if (a.ph_hi > NPHASE) cg::this_grid().sync();
#endif
    XcdBarrier xbar; xbar.bar = (unsigned*)(unsigned char*)a.ws; xbar.x = 0; xbar.st = nullptr;
#if !MK_SPLIT
    xbar = xcd_barrier_post((unsigned*)(unsigned char*)a.ws, (volatile LAS unsigned*)(lds + LDS_BARST));
#endif

    PH_REP(0) if (IN(0)) { PHASE_VARS;
        convert_group<0>(a, ws, lds, gw, NGW, wave, lane);
        if (G != 256) { convert_group<1>(a, ws, lds, gw, NGW, wave, lane); convert_group<2>(a, ws, lds, gw, NGW, wave, lane); }
        for (int m = gw; m < M; m += NGW) row_to_bf16_ss(gptr(a.in[0]) + (size_t)m * DM, h16 + (size_t)m * DM, ss + m, lane);
        for (int m = gw; m < NB * NMEM; m += NGW) row_to_bf16_ss(gptr(a.in[1]) + (size_t)m * DM, (bf16_t*)(ws + WS_MEM16) + (size_t)m * DM, ss + 7 * M + m, lane);
        for (int i = gt; i < 6 * M; i += NGT) ss[M + i] = 0.f;
        for (int i = gt; i < SEQ * 8; i += NGT) { const int t = i >> 3, j = i & 7; const float inv = powf(500000.0f, -(float)j * 0.125f); const float ang = (float)t * inv;
            const double rev = (double)ang * 0.15915494309189535; const float fr = (float)(rev - rint(rev));
            rope[t * 16 + j] = __builtin_amdgcn_cosf(fr); rope[t * 16 + 8 + j] = __builtin_amdgcn_sinf(fr); }
    }
    SEAM(0);

    {
    PH_REP(1) if (IN(1)) { PHASE_VARS;
        { pg8::Gemm g{h16, (const bf16_t*)(ws + WS_WIN), M, 3584, 1024, 1024, 1024, 0, 0}; pg8::StaticOrder S; S.init(M, 3584, G, bid, true);
          EpiProj0 E{ss, rope, (bf16_t*)(ws + A_XBR), (bf16_t*)(ws + A_YG), (bf16_t*)(ws + A_Q), (bf16_t*)(ws + A_K), (bf16_t*)(ws + A_V)};
          pg8::gemm_phase<true>(lds, g, S, E); }
        if (G != 256)
#pragma unroll
        for (int l = 0; l < 2; ++l) { pg8::Gemm g{(const bf16_t*)(ws + WS_MEM16), (const bf16_t*)(ws + WS_XAKV) + (size_t)l * 1024 * 1024, 1024, 1024, 1024, 1024, 1024, 0, 0};
          pg8::StaticOrder S; S.init(1024, 1024, G, (bid + G - (G / 2 + 16 * l) % G) % G);
          EpiScale E{ss + 7 * M, (bf16_t*)(ws + WS_MEMKV) + (size_t)l * 1024 * 1024, 1024};
          pg8::gemm_phase(lds, g, S, E); }
    }
    SEAM(1);
    PH_REP(2) if (IN(2)) { PHASE_VARS;
        const bf16_t* xbr = (const bf16_t*)(ws + A_XBR); bf16_t* xc = h16; const float* cw = gptr(a.in[4]); const float* cb = gptr(a.in[5]);
        for (int i = gt; i < (M / 8) * 128; i += NGT) { const int row0 = (i >> 7) * 8, c8 = (i & 127) * 8;
            f32x4 w0[4], w1[4];
#pragma unroll
            for (int tap = 0; tap < 4; ++tap) { w0[tap] = *(const f32x4*)(cw + tap * 1024 + c8); w1[tap] = *(const f32x4*)(cw + tap * 1024 + c8 + 4); }
            const f32x4 bb0 = *(const f32x4*)(cb + c8), bb1 = *(const f32x4*)(cb + c8 + 4);
            f32x4 xa0, xa1, xb0, xb1, xc0, xc1;
            if ((row0 & (SEQ - 1)) == 0) { xa0 = xa1 = xb0 = xb1 = xc0 = xc1 = (f32x4){0.f, 0.f, 0.f, 0.f}; }
            else { unpack8(*(const u32x4*)(xbr + (size_t)(row0 - 3) * 1024 + c8), xa0, xa1); unpack8(*(const u32x4*)(xbr + (size_t)(row0 - 2) * 1024 + c8), xb0, xb1); unpack8(*(const u32x4*)(xbr + (size_t)(row0 - 1) * 1024 + c8), xc0, xc1); }
            u32x4 xin[8];
#pragma unroll
            for (int r = 0; r < 8; ++r) xin[r] = *(const u32x4*)(xbr + (size_t)(row0 + r) * 1024 + c8);
#pragma unroll
            for (int r = 0; r < 8; ++r) { f32x4 xd0, xd1; unpack8(xin[r], xd0, xd1);
                const f32x4 y0 = bb0 + xa0 * w0[0] + xb0 * w0[1] + xc0 * w0[2] + xd0 * w0[3], y1 = bb1 + xa1 * w1[0] + xb1 * w1[1] + xc1 * w1[2] + xd1 * w1[3];
                *(u32x4*)(xc + (size_t)(row0 + r) * 1024 + c8) = pack8(y0, y1);
                xa0 = xb0; xa1 = xb1; xb0 = xc0; xb1 = xc1; xc0 = xd0; xc1 = xd1; } }
        const bf16_t* q = (const bf16_t*)(ws + A_Q); const bf16_t* k = (const bf16_t*)(ws + A_K); const bf16_t* v = (const bf16_t*)(ws + A_V);
        bf16_t* ob = (bf16_t*)gptr(a.out); float* lse = (float*)((unsigned char*)gptr(a.out) + OUT_LSE);
        { DecL0 dec{q, k, v, ob, lse}; attn_phase<64, 0, 2>(lds, dec, 1536, 0.125f); }
    }
    SEAM(2);
    PH_REP(3) if (IN(3)) { PHASE_VARS;
        pg8::Gemm g{h16, (const bf16_t*)(ws + WS_GT), M, 2048, 256, 1024, 256, 1, 256}; pg8::StaticOrder S; S.init(M, 2048, G, bid);
        EpiGates E{h16, gptr(a.in[7]), gptr(a.in[9]), gptr(a.in[10]), (bf16_t*)(ws + A_XBR), (bf16_t*)(ws + A_U)};
        pg8::gemm_phase(lds, g, S, E);
    }
    SEAM(3);
    PH_REP(4) if (IN(4)) { PHASE_VARS;
        const unsigned* la = (const unsigned*)(ws + A_XBR); const unsigned* uu = (const unsigned*)(ws + A_U);
        float* CA = (float*)(ws + WS_CA); float* CH = (float*)(ws + WS_CH);
        for (int i = gt; i < NB * 64 * 512; i += NGT) { const int cp = i & 511, seg = (i >> 9) & 63, b = i >> 15; const size_t base = ((size_t)b * SEQ + seg * 64) * 512 + cp;
            float A0 = 1.f, A1 = 1.f, H0 = 0.f, H1 = 0.f;
#pragma unroll 32
            for (int t = 0; t < 64; ++t) { const unsigned lw = la[base + (size_t)t * 512], uw = uu[base + (size_t)t * 512];
                const float a0 = __expf(bf_lo(lw)), a1 = __expf(bf_hi(lw)); A0 *= a0; A1 *= a1; H0 = a0 * H0 + bf_lo(uw); H1 = a1 * H1 + bf_hi(uw); }
            const size_t co = ((size_t)b * 64 + seg) * 1024 + cp * 2; CA[co] = A0; CA[co + 1] = A1; CH[co] = H0; CH[co + 1] = H1; }
    }
    SEAM(4);
    PH_REP(5) if (IN(5)) { PHASE_VARS;
        const unsigned* la = (const unsigned*)(ws + A_XBR); const unsigned* uu = (const unsigned*)(ws + A_U); const unsigned* yg = (const unsigned*)(ws + A_YG);
        const float* CA = (const float*)(ws + WS_CA); const float* CH = (const float*)(ws + WS_CH); bf16_t* cat = (bf16_t*)(ws + A_CAT);
        for (int i = gt; i < NB * 64 * 512; i += NGT) { const int cp = i & 511, seg = (i >> 9) & 63, b = i >> 15; const size_t base = ((size_t)b * SEQ + seg * 64) * 512 + cp;
            float H0 = 0.f, H1 = 0.f;
#pragma unroll 16
            for (int s = 0; s < seg; ++s) { const size_t co = ((size_t)b * 64 + s) * 1024 + cp * 2; const f32x2 av = *(const f32x2*)(CA + co), hv = *(const f32x2*)(CH + co); H0 = av.x * H0 + hv.x; H1 = av.y * H1 + hv.y; }
#pragma unroll 16
            for (int t = 0; t < 64; ++t) { const unsigned lw = la[base + (size_t)t * 512], uw = uu[base + (size_t)t * 512], yw = yg[base + (size_t)t * 512];
                H0 = __expf(bf_lo(lw)) * H0 + bf_lo(uw); H1 = __expf(bf_hi(lw)) * H1 + bf_hi(uw);
                *(unsigned*)(cat + ((size_t)b * SEQ + seg * 64 + t) * 1536 + cp * 2) = cvt_pk_bf16(H0 * bf_lo(yw), H1 * bf_hi(yw)); }
        }
        const bf16_t* ob = (const bf16_t*)gptr(a.out); const float* lse = (const float*)((const unsigned char*)gptr(a.out) + OUT_LSE);
        for (int i = gt; i < M * 64; i += NGT) { const int row = i >> 6, c8 = (i & 63) * 8, h = c8 >> 6;
            const float l0 = lse[(size_t)row * 8 + h], l1 = lse[(size_t)M * 8 + (size_t)row * 8 + h], l2 = lse[(size_t)2 * M * 8 + (size_t)row * 8 + h];
            const float mxl = fmaxf(l0, fmaxf(l1, l2)); float w0 = __expf(l0 - mxl), w1 = __expf(l1 - mxl), w2 = __expf(l2 - mxl); const float iw = 1.0f / (w0 + w1 + w2); w0 *= iw; w1 *= iw; w2 *= iw;
            f32x4 a0, a1, b0, b1, c0, c1; unpack8(*(const u32x4*)(ob + (size_t)row * 512 + c8), a0, a1); unpack8(*(const u32x4*)(ob + (size_t)M * 512 + (size_t)row * 512 + c8), b0, b1);
            unpack8(*(const u32x4*)(ob + (size_t)2 * M * 512 + (size_t)row * 512 + c8), c0, c1);
            *(u32x4*)(cat + (size_t)row * 1536 + 1024 + c8) = pack8(a0 * w0 + b0 * w1 + c0 * w2, a1 * w0 + b1 * w1 + c1 * w2); }
    }
    SEAM(5);
    PH_REP(6) if (IN(6)) { PHASE_VARS;
        pg8::Gemm g{(const bf16_t*)(ws + A_CAT), (const bf16_t*)(ws + WS_WOUT), M, 1024, 1536, 1536, 1536, 0, 0}; pg8::StaticOrder S; S.init(M, 1024, G, bid);
        EpiResid<true, false> E{gptr(a.in[0]), nullptr, nullptr, h16, nullptr, ss + 1 * M};
        pg8::gemm_phase(lds, g, S, E);
    }
    SEAM(6);
    }
    xa_ffn<0, 7>(a, lds, lo, hi, xbar);
    {
    PH_REP(12) if (IN(12)) { PHASE_VARS;
        pg8::Gemm g{h16, (const bf16_t*)(ws + WS_CQKV), M, 1280, 1024, 1024, 1024, 0, 0}; pg8::StaticOrder S; S.init(M, 1280, G, bid, true);
        EpiQkv1 E{ss + 3 * M, rope, gptr(a.in[13]), (bf16_t*)(ws + A_Q1), (bf16_t*)(ws + A_KV1)};
        pg8::gemm_phase<true>(lds, g, S, E);
        if (G == 256 && bid >= 128) convert_group<2>(a, ws, lds, (bid - 128) * 8 + wave, 128 * 8, wave, lane);
    }
    SEAM(12);
    PH_REP(13) if (IN(13)) { PHASE_VARS;
        const bf16_t* q = (const bf16_t*)(ws + A_Q1); const bf16_t* kv = (const bf16_t*)(ws + A_KV1); bf16_t* o = (bf16_t*)(ws + A_O1); const float* sinks = gptr(a.in[14]);
        { DecL1 dec{q, kv, o, sinks}; attn_phase<64, 0, 2>(lds, dec, 1024, 0.125f); }
    }
    SEAM(13);
    PH_REP(14) if (IN(14)) { PHASE_VARS;
        pg8::Gemm g{(const bf16_t*)(ws + A_O1), (const bf16_t*)(ws + WS_COUT), M, 1024, 1024, 1024, 1024, 0, 0}; pg8::StaticOrder S; S.init(M, 1024, G, bid);
        EpiResid<false, false> E{nullptr, h16, nullptr, h16, gptr(a.in[16]), ss + 4 * M};
        pg8::gemm_phase(lds, g, S, E);
    }
    SEAM(14);
    }
    xa_ffn<1, 15>(a, lds, lo, hi, xbar);
    PH_REP(20) if (IN(20) && G != 256) { PHASE_VARS;
        const float* fg = gptr(a.in[25]);
        for (int m = gw; m < M; m += NGW) { const float rinv = rsqrtf(ss[6 * M + m] * (1.0f / DM) + EPS); f32x4* xr = (f32x4*)(hbuf + (size_t)m * DM) + lane; const f32x4* gr = (const f32x4*)fg + lane;
#pragma unroll
            for (int j = 0; j < 4; ++j) xr[64 * j] = xr[64 * j] * rinv * gr[64 * j]; }
    }
#undef IN
#undef SEAM
}

extern "C" void kernel_launch(void* const* d_in, const int* in_sizes, int n_in, void* d_out, int out_size, void* d_ws, size_t ws_size, hipStream_t stream) {
    static int grid = 0;
    if (grid == 0) {
        int dev = 0, cus = 0, per_cu = 0;
        if (n_in != 26 || out_size != M * DM || ws_size < 256 * MiB) { fprintf(stderr, "kernel_launch: unexpected shapes (n_in %d out %d ws %zu)\n", n_in, out_size, ws_size); grid = -1; return; }
        hipGetDevice(&dev); hipDeviceGetAttribute(&cus, hipDeviceAttributeMultiprocessorCount, dev);
        if (hipFuncSetAttribute((const void*)fwd_mega, hipFuncAttributeMaxDynamicSharedMemorySize, LDS_BYTES) != hipSuccess) { fprintf(stderr, "kernel_launch: hipFuncSetAttribute failed\n"); grid = -1; return; }
        if (hipOccupancyMaxActiveBlocksPerMultiprocessor(&per_cu, (const void*)fwd_mega, 512, LDS_BYTES) != hipSuccess || per_cu < 1) { fprintf(stderr, "kernel_launch: occupancy query says %d\n", per_cu); per_cu = 1; }
        (void)hipGetLastError();
        grid = cus * 1;
        if (grid <= 0) grid = 256;
    }
    if (grid < 0) return;
    Args a{};
    for (int i = 0; i < 26; ++i) a.in[i] = (const GAS float*)d_in[i];
    a.out = (GAS float*)d_out; a.ws = (GAS unsigned char*)d_ws;
    if (hipMemsetAsync(d_ws, 0, 65536, stream) != hipSuccess) { fprintf(stderr, "kernel_launch: memset failed\n"); return; }
#if MK_SPLIT
    for (int p = 0; p < NPHASE; ++p) { a.ph_lo = p; a.ph_hi = p + 1;
        for (int rep = 0; rep < 1 + ((HOST_REP_MASK >> p) & 1); ++rep) hipLaunchKernelGGL(fwd_mega, dim3(grid), dim3(512), LDS_BYTES, stream, a); }
#else
    a.ph_lo = 0; a.ph_hi = NPHASE;
    void* args[] = {&a};
    hipError_t e = hipLaunchCooperativeKernel((const void*)fwd_mega, dim3(grid), dim3(512), args, LDS_BYTES, stream);
    if (e != hipSuccess) fprintf(stderr, "cooperative launch failed: %s (grid %d)\n", hipGetErrorString(e), grid);
#endif
}
```
